# Optimizing an MI355X kernel written in HIP

```python
import jax, jax.numpy as jnp
from jax import lax
import numpy as np

D_MODEL = 1024
BATCH = 8
SEQ = 2048
DEPTH = 2
DEC_BATCH = 4
DEC_SEQ = 8192
PAST_LEN = 128

HEAD_DIM = 64
ATT_Q_HEADS = 8
ATT_KV_HEADS = 2
ATT_GROUP = ATT_Q_HEADS // ATT_KV_HEADS
ATT_Q_W = ATT_Q_HEADS * HEAD_DIM
ATT_KV_W = ATT_KV_HEADS * HEAD_DIM
WINDOW = 128
BLOCK = 128
RET_HEADS = 4
RET_HEAD_DIM = 128
RET_WIDTH = RET_HEADS * RET_HEAD_DIM
CHUNK = 128
N_BRANCH = 2
D_FF = 2816
CONV_WIDTH = 3
ROPE_THETA = 10000.0
EPS = 1e-6
NEG_INF = -1e30
IN_WIDTH = ATT_Q_W + 2 * ATT_KV_W + 4 * RET_WIDTH + N_BRANCH * D_MODEL

kernel_name = "hybrid_swa_retention_gated_encoder"


def rmsnorm(x, g):
    xf = x.astype(jnp.float32)
    y = xf * lax.rsqrt(jnp.mean(xf * xf, axis=-1, keepdims=True) + EPS)
    return (y * g.astype(jnp.float32)).astype(x.dtype)


def rope(x):
    S, D = x.shape[1], x.shape[-1]
    half = D // 2
    freqs = ROPE_THETA ** (-jnp.arange(half, dtype=jnp.float32) / half)
    ang = jnp.arange(S, dtype=jnp.float32)[:, None] * freqs[None, :]
    cos = jnp.cos(ang)[None, :, None, :]
    sin = jnp.sin(ang)[None, :, None, :]
    xf = x.astype(jnp.float32)
    x1, x2 = xf[..., :half], xf[..., half:]
    out = jnp.concatenate([x1 * cos - x2 * sin, x2 * cos + x1 * sin], axis=-1)
    return out.astype(x.dtype)


def windowed_gqa(q, k, v, sink):
    B, S = q.shape[0], q.shape[1]
    nb = S // BLOCK
    qb = q.reshape(B, nb, BLOCK, ATT_KV_HEADS, ATT_GROUP, HEAD_DIM)
    pad = ((0, 0), (BLOCK, BLOCK), (0, 0), (0, 0))
    kp = jnp.pad(k, pad).reshape(B, nb + 2, BLOCK, ATT_KV_HEADS, HEAD_DIM)
    vp = jnp.pad(v, pad).reshape(B, nb + 2, BLOCK, ATT_KV_HEADS, HEAD_DIM)
    kw = jnp.concatenate([kp[:, :-2], kp[:, 1:-1], kp[:, 2:]], axis=2)
    vw = jnp.concatenate([vp[:, :-2], vp[:, 1:-1], vp[:, 2:]], axis=2)
    scores = jnp.einsum('bnqhgd,bnkhd->bnhgqk', qb, kw).astype(jnp.float32) * (HEAD_DIM ** -0.5)
    r = jnp.arange(BLOCK)[:, None]
    c = jnp.arange(3 * BLOCK)[None, :]
    rel = c - BLOCK - r
    kpos = jnp.arange(nb)[:, None, None] * BLOCK + c[None] - BLOCK
    mask = (jnp.abs(rel) <= WINDOW)[None] & (kpos >= 0) & (kpos < S)
    scores = jnp.where(mask[None, :, None, None], scores, NEG_INF)
    sink_l = sink.astype(jnp.float32).reshape(ATT_KV_HEADS, ATT_GROUP)[None, None, :, :, None, None]
    m = jnp.maximum(jnp.max(scores, axis=-1, keepdims=True), sink_l)
    p = jnp.exp(scores - m)
    denom = jnp.sum(p, axis=-1, keepdims=True) + jnp.exp(sink_l - m)
    out = jnp.einsum('bnhgqk,bnkhd->bnqhgd', (p / denom).astype(v.dtype), vw)
    return out.reshape(B, S, ATT_Q_W)


def retention_dir(q, k, v, log_gamma, strict):
    B, S, H, dk = q.shape
    dv = v.shape[-1]
    nc = S // CHUNK
    qc = q.reshape(B, nc, CHUNK, H, dk)
    kc = k.reshape(B, nc, CHUNK, H, dk)
    vc = v.reshape(B, nc, CHUNK, H, dv)
    idx = jnp.arange(CHUNK, dtype=jnp.float32)
    diff = idx[:, None] - idx[None, :]
    within = (diff > 0) if strict else (diff >= 0)
    dmat = jnp.where(within[None], jnp.exp(log_gamma[:, None, None] * jnp.maximum(diff, 0.0)[None]), 0.0)
    inner = jnp.einsum('bnqhd,bnkhd->bnhqk', qc, kc) * dmat[None, None]
    o_inner = jnp.einsum('bnhqk,bnkhe->bnqhe', inner, vc)
    zeta = jnp.exp(log_gamma[:, None] * (CHUNK - 1 - idx)[None, :])
    kv_chunk = jnp.einsum('bnkhd,hk,bnkhe->bnhde', kc, zeta, vc)
    chunk_decay = jnp.exp(log_gamma * CHUNK)[None, :, None, None]

    def step(state, kv):
        return state * chunk_decay + kv, state

    _, r_prev = lax.scan(step, jnp.zeros((B, H, dk, dv), jnp.float32), jnp.moveaxis(kv_chunk, 1, 0))
    r_prev = jnp.moveaxis(r_prev, 0, 1)
    xi = jnp.exp(log_gamma[:, None] * (idx + 1.0)[None, :])
    o_cross = jnp.einsum('bnqhd,bnhde->bnqhe', qc, r_prev) * xi.T[None, None, :, :, None]
    return (o_inner + o_cross).reshape(B, S, H, dv)


def retention(q, k, v, g, log_decay_f, log_decay_b, norm_g):
    B, S = q.shape[0], q.shape[1]
    dtype = q.dtype
    qh = rope(q.reshape(B, S, RET_HEADS, RET_HEAD_DIM)).astype(jnp.float32)
    kh = rope(k.reshape(B, S, RET_HEADS, RET_HEAD_DIM)).astype(jnp.float32) * (RET_HEAD_DIM ** -0.5)
    vh = v.reshape(B, S, RET_HEADS, RET_HEAD_DIM).astype(jnp.float32)
    lf = log_decay_f.astype(jnp.float32)
    lb = log_decay_b.astype(jnp.float32)
    fwd = retention_dir(qh, kh, vh, lf, strict=False)
    bwd = jnp.flip(retention_dir(jnp.flip(qh, 1), jnp.flip(kh, 1), jnp.flip(vh, 1), lb, strict=True), 1)
    o = fwd + bwd
    o = o * lax.rsqrt(jnp.mean(o * o, axis=-1, keepdims=True) + EPS)
    o = o.reshape(B, S, RET_WIDTH) * norm_g.astype(jnp.float32)
    o = o * jax.nn.silu(g.astype(jnp.float32))
    return o.astype(dtype)


def dwconv_centred(a, w, b):
    S = a.shape[1]
    half = CONV_WIDTH // 2
    ap = jnp.pad(a, ((0, 0), (half, half), (0, 0)))
    out = b[None, None, :]
    for j in range(CONV_WIDTH):
        out = out + ap[:, j:j + S] * w[j][None, None, :]
    return out


def layer(x, norm_mix_g, w_in, attn_sink, log_decay_f, log_decay_b, ret_norm_g,
          w_branch_attn, w_branch_ret, w_out, norm_ffn_g, w_ffn_in, conv_w, conv_b, w_ffn_out):
    B, S = x.shape[0], x.shape[1]
    h = rmsnorm(x, norm_mix_g)
    proj = h @ w_in
    sizes = [ATT_Q_W, ATT_KV_W, ATT_KV_W, RET_WIDTH, RET_WIDTH, RET_WIDTH, RET_WIDTH]
    cuts = []
    acc = 0
    for s_ in sizes:
        acc += s_
        cuts.append(acc)
    q_a, k_a, v_a, q_r, k_r, v_r, g_r, gate = jnp.split(proj, cuts, axis=-1)
    q_a = rope(q_a.reshape(B, S, ATT_Q_HEADS, HEAD_DIM))
    k_a = rope(k_a.reshape(B, S, ATT_KV_HEADS, HEAD_DIM))
    v_a = v_a.reshape(B, S, ATT_KV_HEADS, HEAD_DIM)
    att = windowed_gqa(q_a, k_a, v_a, attn_sink)
    ret = retention(q_r, k_r, v_r, g_r, log_decay_f, log_decay_b, ret_norm_g)
    gates = jax.nn.sigmoid(gate.astype(jnp.float32)).astype(x.dtype).reshape(B, S, N_BRANCH, D_MODEL)
    merged = gates[:, :, 0] * (att @ w_branch_attn) + gates[:, :, 1] * (ret @ w_branch_ret)
    x = x + merged @ w_out
    h = rmsnorm(x, norm_ffn_g)
    a, u = jnp.split(h @ w_ffn_in, 2, axis=-1)
    a = dwconv_centred(a, conv_w, conv_b)
    x = x + (jax.nn.gelu(a, approximate=False) * u) @ w_ffn_out
    return x


def setup_inputs(seed: int = 0) -> dict:
    key = jax.random.key(seed)
    ks = jax.random.split(key, 20)
    f32 = jnp.float32
    nrm = lambda k_, shape, scale: jax.random.normal(k_, shape, f32) * scale
    base_decay = jnp.log(1.0 - 2.0 ** (-5.0 - jnp.arange(RET_HEADS, dtype=f32)))
    return {
        "x_prompt": nrm(ks[0], (BATCH, SEQ, D_MODEL), 1.0),
        "x_sample": nrm(ks[1], (DEC_BATCH, DEC_SEQ, D_MODEL), 1.0),
        "norm_mix_g": 1.0 + nrm(ks[2], (DEPTH, D_MODEL), 0.02),
        "w_in": nrm(ks[3], (DEPTH, D_MODEL, IN_WIDTH), D_MODEL ** -0.5),
        "attn_sink": nrm(ks[4], (DEPTH, ATT_Q_HEADS), 0.5),
        "ret_log_decay_f": base_decay[None, :] * (1.0 + nrm(ks[5], (DEPTH, RET_HEADS), 0.05)),
        "ret_log_decay_b": base_decay[None, :] * (1.0 + nrm(ks[6], (DEPTH, RET_HEADS), 0.05)),
        "ret_norm_g": 1.0 + nrm(ks[7], (DEPTH, RET_WIDTH), 0.02),
        "w_branch_attn": nrm(ks[8], (DEPTH, ATT_Q_W, D_MODEL), ATT_Q_W ** -0.5),
        "w_branch_ret": nrm(ks[9], (DEPTH, RET_WIDTH, D_MODEL), RET_WIDTH ** -0.5),
        "w_out": nrm(ks[10], (DEPTH, D_MODEL, D_MODEL), D_MODEL ** -0.5),
        "norm_ffn_g": 1.0 + nrm(ks[11], (DEPTH, D_MODEL), 0.02),
        "w_ffn_in": nrm(ks[12], (DEPTH, D_MODEL, 2 * D_FF), D_MODEL ** -0.5),
        "conv_w": nrm(ks[13], (DEPTH, CONV_WIDTH, D_FF), CONV_WIDTH ** -0.5),
        "conv_b": nrm(ks[14], (DEPTH, D_FF), 0.01),
        "w_ffn_out": nrm(ks[15], (DEPTH, D_FF, D_MODEL), D_FF ** -0.5),
        "final_norm_g": 1.0 + nrm(ks[16], (D_MODEL,), 0.02),
    }


def reference(x_prompt, x_sample, norm_mix_g, w_in, attn_sink, ret_log_decay_f, ret_log_decay_b,
              ret_norm_g, w_branch_attn, w_branch_ret, w_out, norm_ffn_g, w_ffn_in, conv_w, conv_b,
              w_ffn_out, final_norm_g):
    yp = x_prompt
    ys = x_sample
    for l in range(DEPTH):
        args = (norm_mix_g[l], w_in[l], attn_sink[l], ret_log_decay_f[l], ret_log_decay_b[l], ret_norm_g[l],
                w_branch_attn[l], w_branch_ret[l], w_out[l], norm_ffn_g[l], w_ffn_in[l], conv_w[l], conv_b[l],
                w_ffn_out[l])
        yp = layer(yp, *args)
        ys = layer(ys, *args)
    y_prompt = rmsnorm(yp, final_norm_g)
    y_sample = rmsnorm(ys, final_norm_g)
    return (y_prompt, y_sample)
```

```cpp
#include <hip/hip_runtime.h>
#include <hip/hip_cooperative_groups.h>
#include <cstdio>
namespace cg = cooperative_groups;

#define LAS __attribute__((address_space(3)))
typedef unsigned short bf16_t;
typedef short bf16x8 __attribute__((ext_vector_type(8)));
typedef short s16x4 __attribute__((ext_vector_type(4)));
typedef float f32x4 __attribute__((ext_vector_type(4)));
typedef float f32x2 __attribute__((ext_vector_type(2)));
typedef unsigned u32x4 __attribute__((ext_vector_type(4)));
typedef unsigned u32x2 __attribute__((ext_vector_type(2)));

constexpr int T_ALL = 49152, SLAB = 16384, NSLAB = 3, DM = 1024, INW = 4864, QW = 2816, GW = 2048, FF = 2816, FF2 = 5632, DEPTH = 2;
constexpr int LDS_BYTES = 147456;
constexpr float EPS = 1e-6f;
constexpr size_t SZ_WIN = (size_t)INW * DM * 2, SZ_WBR = (size_t)2048 * 512 * 2, SZ_WOUT = (size_t)DM * DM * 2, SZ_WF1 = (size_t)FF2 * DM * 2, SZ_WF2 = (size_t)DM * FF * 2;
constexpr size_t WS_WIN = 0;
constexpr size_t WS_WBR = WS_WIN + DEPTH * SZ_WIN;
constexpr size_t WS_WOUT = WS_WBR + DEPTH * SZ_WBR;
constexpr size_t WS_WF1 = WS_WOUT + DEPTH * SZ_WOUT;
constexpr size_t WS_WF2 = WS_WF1 + DEPTH * SZ_WF1;
constexpr size_t WS_ROPEA = WS_WF2 + DEPTH * SZ_WF2;
constexpr size_t WS_ROPER = WS_ROPEA + (size_t)8192 * 32 * 8;
constexpr size_t WS_SSQ = WS_ROPER + (size_t)8192 * 64 * 8;
constexpr size_t WS_XB = WS_SSQ + (size_t)T_ALL * 16 * 4;
constexpr size_t WS_SLAB = WS_XB + (size_t)T_ALL * DM * 2;
constexpr size_t SL_QKVG = 0;
constexpr size_t SL_GATES = SL_QKVG + (size_t)SLAB * QW * 2;
constexpr size_t SL_SF = SL_GATES + (size_t)SLAB * GW * 2;
constexpr size_t SL_SB = SL_SF + (size_t)128 * 4 * 16384 * 2;
constexpr size_t SL_MERGED = SL_SB + (size_t)128 * 4 * 16384 * 2;
constexpr size_t SL_ACT = 0;
constexpr size_t WS_BAR = WS_SLAB + SL_MERGED + (size_t)SLAB * DM * 2;
constexpr size_t WS_END = WS_BAR + 16384;

__device__ __forceinline__ int opaque_tid() { int t = threadIdx.x; asm volatile("" : "+v"(t)); return t; }
typedef __bf16 bf16x2_t __attribute__((ext_vector_type(2)));
__device__ __forceinline__ unsigned cvt_pk_bf16(float lo, float hi) { f32x2 v; v.x = lo; v.y = hi; return __builtin_bit_cast(unsigned, __builtin_convertvector(v, bf16x2_t)); }
__device__ __forceinline__ float bf_lo(unsigned u) { return __uint_as_float(u << 16); }
__device__ __forceinline__ float bf_hi(unsigned u) { return __uint_as_float(u & 0xffff0000u); }
__device__ __forceinline__ f32x4 mfma16(bf16x8 a, bf16x8 b, f32x4 c) { return __builtin_amdgcn_mfma_f32_16x16x32_bf16(a, b, c, 0, 0, 0); }

#define PG8_LAS LAS
namespace pg8 {
constexpr int BM = 256, BK = 64, HALF = 128, HTB = HALF * BK * 2  , STAGE_BYTES = 8 * HTB, NXCD = 8, WGM = 8;
__host__ __device__ __forceinline__ int lds_byte(int r, int c) { const int st = (r >> 4) * 2 + (c >> 5), rr = r & 15, cc = c & 31, ob = rr * 64 + cc * 2; return st * 1024 + (ob ^ (((ob >> 9) & 1) << 5)); }
__host__ __device__ __forceinline__ void stage_rc(int b, int& R, int& C) { const int st = b / 1024, sb = b % 1024, swz = sb ^ (((sb >> 9) & 1) << 5); R = (st >> 1) * 16 + swz / 64; C = (st & 1) * 32 + (swz % 64) / 2; }
__host__ __device__ __forceinline__ int perm32(int rho) { const int n = rho >> 4, i = rho & 15; return 8 * (i >> 2) + 4 * n + (i & 3); }

struct Unit { int pm, pn, asel, arow; };
struct Gemm { const bf16_t* A; const bf16_t* A2; const bf16_t* Bt; int K, lda, ldb; };

struct StaticOrder {
    int nM, nN, nwg, G, c;
    __device__ void init(int M, int N, int G_, int c_) { nM = M / BM; nN = N / BM; nwg = nM * nN; G = G_; c = c_; }
    __device__ bool next(int i, Unit& u) const {
        const long L = (long)i * G + c; if (L >= nwg) return false;
        int wgid = (int)L; { const int q = nwg / NXCD, r = nwg % NXCD, xcd = wgid % NXCD, off = wgid / NXCD; wgid = (xcd < r ? xcd * (q + 1) : r * (q + 1) + (xcd - r) * q) + off; }
        const int nig = WGM * nN, gid = wgid / nig, fm = gid * WGM, gsz = (nM - fm) < WGM ? (nM - fm) : WGM;
        u.pm = fm + ((wgid % nig) % gsz); u.pn = (wgid % nig) / gsz; u.asel = 0; u.arow = u.pm * BM; return true;
    }
};
struct MergeOrder {
    int ntile, G, c;
    __device__ void init(int M, int G_, int c_) { ntile = (M / BM) * 4; G = G_; c = c_; }
    __device__ bool next(int i, Unit& u) const {
        const long t = (long)(i >> 1) * G + c; if (t >= ntile) return false;
        u.pm = (int)(t >> 2); u.asel = i & 1; u.pn = (int)(t & 3) + 4 * u.asel; u.arow = u.pm * BM; return true;
    }
};

struct FfnOrder {
    StaticOrder so;
    __device__ void init(int nMt, int N, int G_, int c_) { so.init(nMt * BM, N, G_, c_); }
    __device__ bool next(int i, Unit& u) const {
        if (!so.next(i, u)) return false;
        u.arow = 254 * u.pm - 1; return true;
    }
};

template <class Epi, class Sched>
__device__ __forceinline__ void gemm_phase(PG8_LAS unsigned char* lds, const Gemm g, const Sched& S, const Epi& E) {
    const int tid = opaque_tid(), wid = __builtin_amdgcn_readfirstlane(tid >> 6), lane = tid & 63, wr = wid >> 2, wc = wid & 3, fr = lane & 15, fq = lane >> 4;
    const int K = g.K, nt = K / BK;
    unsigned voffA[2], voffB[2];
#pragma unroll
    for (int i = 0; i < 2; ++i) { int R, C; stage_rc(tid * 16 + i * 8192, R, C); const int Rb = Epi::PERM ? ((R & ~31) + perm32(R & 31)) : R;
        voffA[i] = (unsigned)(R * g.lda + C) * 2u; voffB[i] = (unsigned)(Rb * g.ldb + C) * 2u; }
    const size_t kstep = (size_t)(BK * 2);
    const size_t hstepA = (size_t)HALF * g.lda * 2, hstepB = (size_t)HALF * g.ldb * 2;
    const size_t tstepB = 2 * hstepB;
    const unsigned ldsw = (unsigned)wid * 1024u;
    const int aoff = lds_byte(wr * 64 + fr, fq * 8), boff = lds_byte(wc * 32 + fr, fq * 8);
#define PG8_SA(b, h) (((b) * 2 + (h)) * HTB)
#define PG8_SB(b, h) ((4 + (b) * 2 + (h)) * HTB)
#define PG8_STAGE(bufoff, gbase, voff) do { _Pragma("unroll") for (int _i = 0; _i < 2; ++_i) \
        __builtin_amdgcn_global_load_lds((const unsigned*)((const char*)(gbase) + (voff)[_i]), (PG8_LAS unsigned*)(lds + (bufoff) + ldsw + _i * 8192), 16, 0, 0); } while (0)
#define PG8_LDA(dst, b, h) do { _Pragma("unroll") for (int m = 0; m < 4; ++m) _Pragma("unroll") for (int k = 0; k < 2; ++k) dst[m][k] = *(const PG8_LAS bf16x8*)(lds + PG8_SA(b, h) + aoff + m * 2048 + k * 1024); } while (0)
#define PG8_LDB(dst, b, h) do { _Pragma("unroll") for (int n = 0; n < 2; ++n) _Pragma("unroll") for (int k = 0; k < 2; ++k) dst[n][k] = *(const PG8_LAS bf16x8*)(lds + PG8_SB(b, h) + boff + n * 2048 + k * 1024); } while (0)
#define PG8_MMA(ai, bj, At, Bt) do { __builtin_amdgcn_s_setprio(1); _Pragma("unroll") for (int m = 0; m < 4; ++m) _Pragma("unroll") for (int n = 0; n < 2; ++n) _Pragma("unroll") for (int k = 0; k < 2; ++k) \
        acc[ai][bj][m][n] = __builtin_amdgcn_mfma_f32_16x16x32_bf16(Bt[n][k], At[m][k], acc[ai][bj][m][n], 0, 0, 0); __builtin_amdgcn_s_setprio(0); } while (0)
#define PG8_WAIT_V(n) asm volatile("s_waitcnt vmcnt(" #n ")" ::: "memory")
#define PG8_WAIT_L(n) asm volatile("s_waitcnt lgkmcnt(" #n ")" ::: "memory")
#define PG8_BAR __builtin_amdgcn_s_barrier()
#define PG8_SCHED __builtin_amdgcn_sched_barrier(0)
    Unit cur, nxt; int ui = 0;
    if (!S.next(0, cur)) return;
    f32x4 acc[2][2][4][2];
#pragma unroll
    for (int a = 0; a < 2; ++a)
#pragma unroll
        for (int b = 0; b < 2; ++b)
#pragma unroll
            for (int m = 0; m < 4; ++m)
#pragma unroll
                for (int n = 0; n < 2; ++n) acc[a][b][m][n] = (f32x4){0.f, 0.f, 0.f, 0.f};
    bf16x8 At[4][2], B0[2][2], B1[2][2];
    const long rstepA = (long)g.lda * 2;
    const char* cA = (const char*)(cur.asel ? g.A2 : g.A) + (long)cur.arow * rstepA; const char* cB = (const char*)g.Bt + (size_t)cur.pn * tstepB;
    PG8_STAGE(PG8_SB(0, 0), cB, voffB); PG8_STAGE(PG8_SA(0, 0), cA, voffA); PG8_STAGE(PG8_SB(0, 1), cB + hstepB, voffB); PG8_STAGE(PG8_SA(0, 1), cA + hstepA, voffA);
    if (wr == 1) PG8_BAR;
    PG8_WAIT_V(4); PG8_BAR;
    PG8_STAGE(PG8_SB(1, 0), cB + kstep, voffB); PG8_STAGE(PG8_SA(1, 0), cA + kstep, voffA); PG8_STAGE(PG8_SB(1, 1), cB + hstepB + kstep, voffB);
    PG8_WAIT_V(6); PG8_BAR;
    for (;;) {
        const bool has_next = S.next(ui + 1, nxt);
        const char* nA = has_next ? (const char*)(nxt.asel ? g.A2 : g.A) + (long)nxt.arow * rstepA : cA; const char* nB = has_next ? (const char*)g.Bt + (size_t)nxt.pn * tstepB : cB;
        for (int t = 0; t < nt; t += 2) {
            const bool last = (t == nt - 2);
            const char* a1 = cA + (size_t)(t + 1) * kstep;
            const char* a2 = last ? nA : cA + (size_t)(t + 2) * kstep; const char* b2 = last ? nB : cB + (size_t)(t + 2) * kstep;
            const char* a3 = a2 + kstep; const char* b3 = b2 + kstep;
            PG8_LDB(B0, 0, 0); PG8_SCHED; PG8_LDA(At, 0, 0); PG8_STAGE(PG8_SA(1, 1), a1 + hstepA, voffA);
            PG8_WAIT_L(8); PG8_BAR; PG8_WAIT_L(0); PG8_MMA(0, 0, At, B0); PG8_BAR; PG8_SCHED;
            PG8_LDB(B1, 0, 1); PG8_STAGE(PG8_SB(0, 0), b2, voffB);
            PG8_BAR; PG8_WAIT_L(0); PG8_MMA(0, 1, At, B1); PG8_BAR;
            PG8_LDA(At, 0, 1); PG8_STAGE(PG8_SA(0, 0), a2, voffA);
            PG8_BAR; PG8_WAIT_L(0); PG8_MMA(1, 0, At, B0); PG8_BAR; PG8_SCHED;
            PG8_STAGE(PG8_SB(0, 1), b2 + hstepB, voffB);
            PG8_WAIT_V(6); PG8_BAR; PG8_MMA(1, 1, At, B1); PG8_BAR;
            PG8_LDB(B0, 1, 0); PG8_SCHED; PG8_LDA(At, 1, 0); PG8_STAGE(PG8_SA(0, 1), a2 + hstepA, voffA);
            PG8_WAIT_L(8); PG8_BAR; PG8_WAIT_L(0); PG8_MMA(0, 0, At, B0); PG8_BAR; PG8_SCHED;
            PG8_LDB(B1, 1, 1); PG8_STAGE(PG8_SB(1, 0), b3, voffB);
            PG8_BAR; PG8_WAIT_L(0); PG8_MMA(0, 1, At, B1); PG8_BAR;
            PG8_LDA(At, 1, 1); PG8_STAGE(PG8_SA(1, 0), a3, voffA);
            PG8_BAR; PG8_WAIT_L(0); PG8_MMA(1, 0, At, B0); PG8_BAR; PG8_SCHED;
            PG8_STAGE(PG8_SB(1, 1), b3 + hstepB, voffB);
            PG8_WAIT_V(6); PG8_BAR; PG8_MMA(1, 1, At, B1); PG8_BAR;
        }
        E(acc, cur, wr, wc, fr, fq);
        if (!has_next) break;
        if (!Epi::keep_acc(cur))
#pragma unroll
        for (int a = 0; a < 2; ++a)
#pragma unroll
            for (int b = 0; b < 2; ++b)
#pragma unroll
                for (int m = 0; m < 4; ++m)
#pragma unroll
                    for (int n = 0; n < 2; ++n) acc[a][b][m][n] = (f32x4){0.f, 0.f, 0.f, 0.f};
        cur = nxt; cA = nA; cB = nB; ++ui;
    }
    PG8_WAIT_V(0);
    if (wr == 0) PG8_BAR;
    PG8_BAR;
#undef PG8_SA
#undef PG8_SB
#undef PG8_STAGE
#undef PG8_LDA
#undef PG8_LDB
#undef PG8_MMA
#undef PG8_WAIT_V
#undef PG8_WAIT_L
#undef PG8_BAR
#undef PG8_SCHED
}
}

using pg8::Unit;
__device__ __forceinline__ float row_rinv(const float* ssq, int row, int fq) {
    const f32x4 p = *(const f32x4*)(ssq + (size_t)row * 16 + 4 * fq);
    float s = (p[0] + p[1]) + (p[2] + p[3]);
    s += __shfl_xor(s, 16); s += __shfl_xor(s, 32);
    return __builtin_amdgcn_rsqf(s * (1.0f / 1024.0f) + EPS);
}
__device__ __forceinline__ float sigmoid_f(float x) { return __builtin_amdgcn_rcpf(1.0f + __expf(-x)); }

__device__ __forceinline__ f32x2 gelu_pk(f32x2 v) {
    const f32x2 av = __builtin_elementwise_abs(v), d = av * 0.2316418882f + 1.0f;
    f32x2 t; t.x = __builtin_amdgcn_rcpf(d.x); t.y = __builtin_amdgcn_rcpf(d.y);
    f32x2 q = t * 0.5307027145f + (-0.7265760135f); q = q * t + 0.7107068705f; q = q * t + (-0.142248368f); q = q * t + 0.127414796f; q = q * t;
    const f32x2 s = (v * v) * (-0.72134752044f);
    f32x2 e; e.x = __builtin_amdgcn_exp2f(s.x); e.y = __builtin_amdgcn_exp2f(s.y);
    const f32x2 m = v * (q * e);
    f32x2 o; o.x = fmaxf(v.x, 0.f) - fabsf(m.x); o.y = fmaxf(v.y, 0.f) - fabsf(m.y); return o;
}

struct EpiProj {
    static constexpr bool PERM = true;
    static __device__ __forceinline__ bool keep_acc(const Unit&) { return false; }
    bf16_t* qkvg; bf16_t* gates; const float* ssq; const f32x4* ropeA; const f32x4* ropeR; int seqmask;
    __device__ __forceinline__ void operator()(f32x4 (&acc)[2][2][4][2], const Unit& u, int wr, int wc, int fr, int fq) const {
        const int pn = u.pn, rowb = u.pm * 256 + wr * 64 + fr;
        bf16_t* dst = qkvg; int ld = QW, col0, col1, tabw = 0, i0 = 0; bool rope = false, sigm = false; float scale = 1.0f; const f32x4* tab = ropeA;
        if (pn >= 11) { dst = gates; ld = GW; col0 = 256 * (pn - 11) + 32 * wc + 8 * fq; col1 = col0 + 128; sigm = true; scale = -1.4426950408889634f; }
        else if (pn >= 7) { col0 = 256 * pn + 32 * wc + 8 * fq; col1 = col0 + 128; }
        else if (pn >= 3) { rope = true; tab = ropeR; tabw = 64; i0 = 32 * (wc & 1) + 8 * fq; col0 = 256 * pn + 128 * (wc >> 1) + i0; col1 = col0 + 64; scale = pn >= 5 ? 0.08838834764831845f : 1.0f; }
        else if (pn == 2 && wc >= 2) { col0 = 640 + 32 * (wc - 2) + 8 * fq; col1 = col0 + 64; }
        else { rope = true; tab = ropeA; tabw = 32; i0 = 8 * fq; col0 = (pn < 2 ? 256 * pn : 512) + 64 * wc + i0; col1 = col0 + 32; scale = pn < 2 ? 0.18033688011112042f   : 1.0f; }
        float rsv[2][4];
        {
            f32x4 sq[2][4];
#pragma unroll
            for (int ai = 0; ai < 2; ++ai)
#pragma unroll
                for (int m = 0; m < 4; ++m) sq[ai][m] = *(const f32x4*)(ssq + (size_t)(rowb + ai * 128 + m * 16) * 16 + 4 * fq);
#pragma unroll
            for (int ai = 0; ai < 2; ++ai)
#pragma unroll
                for (int m = 0; m < 4; ++m) {
                    float s = (sq[ai][m][0] + sq[ai][m][1]) + (sq[ai][m][2] + sq[ai][m][3]);
                    s += __shfl_xor(s, 16); s += __shfl_xor(s, 32);
                    rsv[ai][m] = __builtin_amdgcn_rsqf(s * (1.0f / 1024.0f) + EPS) * scale;
                }
        }
#pragma unroll
        for (int am = 0; am < 4; ++am) {
            const int ai = am >> 1;
            f32x4 tb[2][4];
            if (rope) {
#pragma unroll
                for (int mm = 0; mm < 2; ++mm) { const int m = 2 * (am & 1) + mm; const f32x4* tp = tab + ((size_t)((rowb + ai * 128 + m * 16) & seqmask) * tabw + i0) / 2;
#pragma unroll
                    for (int q = 0; q < 4; ++q) tb[mm][q] = tp[q]; }
            }
#pragma unroll
            for (int mm = 0; mm < 2; ++mm) {
                const int m = 2 * (am & 1) + mm;
                const int row = rowb + ai * 128 + m * 16;
                const float rs = rsv[ai][m];
                f32x4 a0 = acc[ai][0][m][0] * rs, a1 = acc[ai][0][m][1] * rs, b0 = acc[ai][1][m][0] * rs, b1 = acc[ai][1][m][1] * rs;
                if (rope) {
                    const f32x4 t0 = tb[mm][0], t1 = tb[mm][1], t2 = tb[mm][2], t3 = tb[mm][3];
                    f32x4 x, y;
                    x[0] = a0[0] * t0[0] - b0[0] * t0[1]; y[0] = b0[0] * t0[0] + a0[0] * t0[1];
                    x[1] = a0[1] * t0[2] - b0[1] * t0[3]; y[1] = b0[1] * t0[2] + a0[1] * t0[3];
                    x[2] = a0[2] * t1[0] - b0[2] * t1[1]; y[2] = b0[2] * t1[0] + a0[2] * t1[1];
                    x[3] = a0[3] * t1[2] - b0[3] * t1[3]; y[3] = b0[3] * t1[2] + a0[3] * t1[3];
                    a0 = x; b0 = y;
                    x[0] = a1[0] * t2[0] - b1[0] * t2[1]; y[0] = b1[0] * t2[0] + a1[0] * t2[1];
                    x[1] = a1[1] * t2[2] - b1[1] * t2[3]; y[1] = b1[1] * t2[2] + a1[1] * t2[3];
                    x[2] = a1[2] * t3[0] - b1[2] * t3[1]; y[2] = b1[2] * t3[0] + a1[2] * t3[1];
                    x[3] = a1[3] * t3[2] - b1[3] * t3[3]; y[3] = b1[3] * t3[2] + a1[3] * t3[3];
                    a1 = x; b1 = y;
                }
                if (sigm) {
#pragma unroll
                    for (int j = 0; j < 4; ++j) { a0[j] = __builtin_amdgcn_rcpf(1.0f + __builtin_amdgcn_exp2f(a0[j])); a1[j] = __builtin_amdgcn_rcpf(1.0f + __builtin_amdgcn_exp2f(a1[j])); b0[j] = __builtin_amdgcn_rcpf(1.0f + __builtin_amdgcn_exp2f(b0[j])); b1[j] = __builtin_amdgcn_rcpf(1.0f + __builtin_amdgcn_exp2f(b1[j])); }
                }
                u32x4 w0, w1;
                w0.x = cvt_pk_bf16(a0[0], a0[1]); w0.y = cvt_pk_bf16(a0[2], a0[3]); w0.z = cvt_pk_bf16(a1[0], a1[1]); w0.w = cvt_pk_bf16(a1[2], a1[3]);
                w1.x = cvt_pk_bf16(b0[0], b0[1]); w1.y = cvt_pk_bf16(b0[2], b0[3]); w1.z = cvt_pk_bf16(b1[0], b1[1]); w1.w = cvt_pk_bf16(b1[2], b1[3]);
                bf16_t* rp = dst + (size_t)row * ld;
                *(u32x4*)(rp + col0) = w0; *(u32x4*)(rp + col1) = w1;
            }
        }
    }
};

struct EpiMerge {
    static constexpr bool PERM = true;
    static __device__ __forceinline__ bool keep_acc(const Unit& u) { return u.asel == 0; }
    bf16_t* merged; const bf16_t* gates;
    __device__ __forceinline__ void operator()(f32x4 (&acc)[2][2][4][2], const Unit& u, int wr, int wc, int fr, int fq) const {
        const int type = u.asel, rowb = u.pm * 256 + wr * 64 + fr, colb = 256 * (u.pn & 3) + 32 * wc + 8 * fq;
#pragma unroll
        for (int ai = 0; ai < 2; ++ai) {
            u32x4 g0q[4][2], g1q[4][2];
#pragma unroll
            for (int m = 0; m < 4; ++m)
#pragma unroll
                for (int bj = 0; bj < 2; ++bj) {
                    const bf16_t* gp = gates + (size_t)(rowb + ai * 128 + m * 16) * GW + colb + 128 * bj;
                    g1q[m][bj] = *(const u32x4*)(gp + 1024);
                    if (!type) g0q[m][bj] = *(const u32x4*)gp;
                }
#pragma unroll
            for (int m = 0; m < 4; ++m)
#pragma unroll
                for (int bj = 0; bj < 2; ++bj) {
                    const u32x4 g1 = g1q[m][bj];
                    f32x4 s0 = (f32x4){bf_lo(g1.x), bf_hi(g1.x), bf_lo(g1.y), bf_hi(g1.y)}, s1 = (f32x4){bf_lo(g1.z), bf_hi(g1.z), bf_lo(g1.w), bf_hi(g1.w)};
                    if (!type) {
                        const u32x4 g0 = g0q[m][bj];
#pragma unroll
                        for (int j = 0; j < 4; ++j) { s0[j] = __builtin_amdgcn_rcpf(fmaxf(s0[j], 1e-30f)); s1[j] = __builtin_amdgcn_rcpf(fmaxf(s1[j], 1e-30f)); }
                        s0 = s0 * (f32x4){bf_lo(g0.x), bf_hi(g0.x), bf_lo(g0.y), bf_hi(g0.y)}; s1 = s1 * (f32x4){bf_lo(g0.z), bf_hi(g0.z), bf_lo(g0.w), bf_hi(g0.w)};
                        acc[ai][bj][m][0] = acc[ai][bj][m][0] * s0; acc[ai][bj][m][1] = acc[ai][bj][m][1] * s1;
                    } else {
                        const f32x4 v0 = acc[ai][bj][m][0] * s0, v1 = acc[ai][bj][m][1] * s1;
                        u32x4 w; w.x = cvt_pk_bf16(v0[0], v0[1]); w.y = cvt_pk_bf16(v0[2], v0[3]); w.z = cvt_pk_bf16(v1[0], v1[1]); w.w = cvt_pk_bf16(v1[2], v1[3]);
                        *(u32x4*)(merged + (size_t)(rowb + ai * 128 + m * 16) * DM + colb + 128 * bj) = w;
                    }
                }
        }
    }
};

template <bool SRC_F32> struct EpiResid {
    static constexpr bool PERM = true;
    static __device__ __forceinline__ bool keep_acc(const Unit&) { return false; }
    const float* xsrc; bf16_t* xb; float* ssq;
    __device__ __forceinline__ void operator()(f32x4 (&acc)[2][2][4][2], const Unit& u, int wr, int wc, int fr, int fq) const {
        const int rowb = u.pm * 256 + wr * 64 + fr, colb = u.pn * 256 + wc * 32 + 8 * fq;
#pragma unroll
        for (int ai = 0; ai < 2; ++ai) {
            f32x4 x0[4][2], x1[4][2];
#pragma unroll
            for (int m = 0; m < 4; ++m)
#pragma unroll
                for (int bj = 0; bj < 2; ++bj) {
                    const size_t o = (size_t)(rowb + ai * 128 + m * 16) * DM + colb + bj * 128;
                    if (SRC_F32) { x0[m][bj] = *(const f32x4*)(xsrc + o); x1[m][bj] = *(const f32x4*)(xsrc + o + 4); }
                    else { const u32x4 q = *(const u32x4*)(xb + o); x0[m][bj] = (f32x4){bf_lo(q.x), bf_hi(q.x), bf_lo(q.y), bf_hi(q.y)}; x1[m][bj] = (f32x4){bf_lo(q.z), bf_hi(q.z), bf_lo(q.w), bf_hi(q.w)}; }
                }
#pragma unroll
            for (int m = 0; m < 4; ++m) {
                const int row = rowb + ai * 128 + m * 16; float part = 0.f;
#pragma unroll
                for (int bj = 0; bj < 2; ++bj) {
                    const f32x4 a = x0[m][bj] + acc[ai][bj][m][0], b = x1[m][bj] + acc[ai][bj][m][1];
                    u32x4 w; w.x = cvt_pk_bf16(a[0], a[1]); w.y = cvt_pk_bf16(a[2], a[3]); w.z = cvt_pk_bf16(b[0], b[1]); w.w = cvt_pk_bf16(b[2], b[3]);
                    *(u32x4*)(xb + (size_t)row * DM + colb + bj * 128) = w;
                    part += ((a[0] * a[0] + a[1] * a[1]) + (a[2] * a[2] + a[3] * a[3])) + ((b[0] * b[0] + b[1] * b[1]) + (b[2] * b[2] + b[3] * b[3]));
                }
                part += __shfl_xor(part, 16); part += __shfl_xor(part, 32);
                if (fq == 0) ssq[(size_t)row * 16 + u.pn * 4 + wc] = part;
            }
        }
    }
};

__device__ __forceinline__ float dpp_prev(float v, float old) { return __builtin_bit_cast(float, __builtin_amdgcn_update_dpp(__builtin_bit_cast(int, old), __builtin_bit_cast(int, v), 0x111, 0xf, 0xf, false)); }
__device__ __forceinline__ float dpp_next(float v, float old) { return __builtin_bit_cast(float, __builtin_amdgcn_update_dpp(__builtin_bit_cast(int, old), __builtin_bit_cast(int, v), 0x101, 0xf, 0xf, false)); }
__device__ __forceinline__ float dpp_ror1(float v) { return __builtin_bit_cast(float, __builtin_amdgcn_mov_dpp(__builtin_bit_cast(int, v), 0x121, 0xf, 0xf, true)); }
__device__ __forceinline__ float dpp_ror15(float v) { return __builtin_bit_cast(float, __builtin_amdgcn_mov_dpp(__builtin_bit_cast(int, v), 0x12f, 0xf, 0xf, true)); }
struct EpiFfnConv {
    static constexpr bool PERM = true;
    static __device__ __forceinline__ bool keep_acc(const Unit&) { return false; }
    bf16_t* act; const float* ssq; const float* cw; const float* cb; LAS float* X; int S;
    __device__ __forceinline__ void operator()(f32x4 (&acc)[2][2][4][2], const Unit& u, int wr, int wc, int fr, int fq) const {
        asm volatile("" : "+v"(fr), "+v"(fq));
        const int row0 = 254 * u.pm - 1, f0 = 128 * u.pn + 32 * wc + 8 * fq, ib = 64 * wr + fr;
        const bool edge = row0 < 0 || ((row0 + 1) & ~(S - 1)) != ((row0 + 256) & ~(S - 1)) || (row0 & ~(S - 1)) != ((row0 + 255) & ~(S - 1));
        f32x4 w0[2], w1[2], w2[2], bb[2];
#pragma unroll
        for (int n = 0; n < 2; ++n) { w0[n] = *(const f32x4*)(cw + f0 + 4 * n); w1[n] = *(const f32x4*)(cw + FF + f0 + 4 * n); w2[n] = *(const f32x4*)(cw + 2 * FF + f0 + 4 * n); bb[n] = *(const f32x4*)(cb + f0 + 4 * n); }
        f32x4 av[2][4][2], uv[2][4][2];
        {
            f32x4 sq[2][4];
#pragma unroll
            for (int ai = 0; ai < 2; ++ai)
#pragma unroll
                for (int m = 0; m < 4; ++m) { int row = row0 + 128 * ai + 16 * m + ib; row = row < 0 ? 0 : (row > SLAB - 1 ? SLAB - 1 : row); sq[ai][m] = *(const f32x4*)(ssq + (size_t)row * 16 + 4 * fq); }
#pragma unroll
            for (int ai = 0; ai < 2; ++ai)
#pragma unroll
                for (int m = 0; m < 4; ++m) {
                    float s = (sq[ai][m][0] + sq[ai][m][1]) + (sq[ai][m][2] + sq[ai][m][3]);
                    s += __shfl_xor(s, 16); s += __shfl_xor(s, 32);
                    const float rs = __builtin_amdgcn_rsqf(s * (1.0f / 1024.0f) + EPS);
#pragma unroll
                    for (int n = 0; n < 2; ++n) { av[ai][m][n] = acc[ai][0][m][n] * rs; uv[ai][m][n] = acc[ai][1][m][n] * rs; }
                }
        }
        const int xo = 32 * wc + 8 * fq;
#pragma unroll
        for (int ai = 0; ai < 2; ++ai) {
            if (fr == 0) { *(LAS f32x4*)(X + ((2 * ai + wr) * 2 + 0) * 128 + xo) = av[ai][0][0]; *(LAS f32x4*)(X + ((2 * ai + wr) * 2 + 0) * 128 + xo + 4) = av[ai][0][1]; }
            if (fr == 15) { *(LAS f32x4*)(X + ((2 * ai + wr) * 2 + 1) * 128 + xo) = av[ai][3][0]; *(LAS f32x4*)(X + ((2 * ai + wr) * 2 + 1) * 128 + xo + 4) = av[ai][3][1]; }
        }
        asm volatile("s_waitcnt lgkmcnt(0)" ::: "memory"); __builtin_amdgcn_s_barrier(); asm volatile("" ::: "memory"); __builtin_amdgcn_s_barrier(); asm volatile("" ::: "memory");
#pragma unroll
        for (int ai = 0; ai < 2; ++ai) {
            const int g4 = 2 * ai + wr, gp = g4 > 0 ? g4 - 1 : 0, gn = g4 < 3 ? g4 + 1 : 3;
            f32x4 xp[2], xn[2];
#pragma unroll
            for (int n = 0; n < 2; ++n) { xp[n] = *(const LAS f32x4*)(X + (gp * 2 + 1) * 128 + xo + 4 * n); xn[n] = *(const LAS f32x4*)(X + (gn * 2 + 0) * 128 + xo + 4 * n); }
#pragma unroll
            for (int m = 0; m < 4; ++m) {
                const int i = 128 * ai + 16 * m + ib, row = row0 + i, pos = row & (S - 1);
                u32x4 o;
#pragma unroll
                for (int n = 0; n < 2; ++n) {
                    f32x4 pv, nv;
#pragma unroll
                    for (int e = 0; e < 4; ++e) {
                        const float a = av[ai][m][n][e];
                        pv[e] = dpp_prev(a, m > 0 ? dpp_ror1(av[ai][m > 0 ? m - 1 : 0][n][e]) : xp[n][e]);
                        nv[e] = dpp_next(a, m < 3 ? dpp_ror15(av[ai][m < 3 ? m + 1 : 3][n][e]) : xn[n][e]);
                    }
                    if (edge) {
#pragma unroll
                        for (int e = 0; e < 4; ++e) { pv[e] = pos == 0 ? 0.f : pv[e]; nv[e] = pos == S - 1 ? 0.f : nv[e]; }
                    }
                    const f32x4 v = bb[n] + w0[n] * pv + w1[n] * av[ai][m][n] + w2[n] * nv;
                    const f32x2 g01 = gelu_pk((f32x2){v[0], v[1]}), g23 = gelu_pk((f32x2){v[2], v[3]});
                    const f32x4 uu = uv[ai][m][n];
                    if (n == 0) { o.x = cvt_pk_bf16(g01.x * uu[0], g01.y * uu[1]); o.y = cvt_pk_bf16(g23.x * uu[2], g23.y * uu[3]); }
                    else { o.z = cvt_pk_bf16(g01.x * uu[0], g01.y * uu[1]); o.w = cvt_pk_bf16(g23.x * uu[2], g23.y * uu[3]); }
                }
                if (i >= 1 && i <= 254 && row < SLAB) *(u32x4*)(act + (size_t)row * FF + f0) = o;
            }
        }
    }
};

#define TR8(base, O0, O1, O2, O3, O4, O5, O6, O7, r) \
    asm volatile("ds_read_b64_tr_b16 %0, %8 offset:" #O0 "\n\tds_read_b64_tr_b16 %1, %8 offset:" #O1 "\n\tds_read_b64_tr_b16 %2, %8 offset:" #O2 "\n\tds_read_b64_tr_b16 %3, %8 offset:" #O3 "\n\t" \
                 "ds_read_b64_tr_b16 %4, %8 offset:" #O4 "\n\tds_read_b64_tr_b16 %5, %8 offset:" #O5 "\n\tds_read_b64_tr_b16 %6, %8 offset:" #O6 "\n\tds_read_b64_tr_b16 %7, %8 offset:" #O7 "\n\t" \
                 "s_waitcnt lgkmcnt(0)" \
                 : "=&v"(r[0]), "=&v"(r[1]), "=&v"(r[2]), "=&v"(r[3]), "=&v"(r[4]), "=&v"(r[5]), "=&v"(r[6]), "=&v"(r[7]) : "v"(base) : "memory")
__device__ __forceinline__ bf16x8 cat4(s16x4 lo, s16x4 hi) { return __builtin_shufflevector(lo, hi, 0, 1, 2, 3, 4, 5, 6, 7); }
__device__ __forceinline__ bf16x8 pack8(f32x4 a, f32x4 b) { u32x4 w; w.x = cvt_pk_bf16(a[0], a[1]); w.y = cvt_pk_bf16(a[2], a[3]); w.z = cvt_pk_bf16(b[0], b[1]); w.w = cvt_pk_bf16(b[2], b[3]); return __builtin_bit_cast(bf16x8, w); }
__device__ __forceinline__ unsigned lds_addr(LAS unsigned char* p) { return (unsigned)(size_t)p; }

constexpr int AP = 144;
struct AttnKV { u32x4 k[6], v[6]; };
__device__ __forceinline__ void attn_load(AttnKV& r, const bf16_t* qkvg, int item, int nbs) {
    const int tid = opaque_tid(), bi = item >> 1, hk = item & 1, bis = bi & (nbs - 1), row0 = bi * 128;
    const bool has_prev = bis > 0, has_next = bis < nbs - 1;
#pragma unroll
    for (int i = 0; i < 6; ++i) {
        const int c = tid + 512 * i, rr = c >> 3, ch = c & 7, jb = rr >> 7;
        const bool valid = (jb == 1) || (jb == 0 ? has_prev : has_next);
        r.k[i] = (u32x4){0u, 0u, 0u, 0u}; r.v[i] = (u32x4){0u, 0u, 0u, 0u};
        if (valid) { const bf16_t* p = qkvg + (size_t)(row0 - 128 + rr) * QW + 512 + hk * 64 + ch * 8; r.k[i] = *(const u32x4*)p; r.v[i] = *(const u32x4*)(p + 128); }
    }
}
__device__ __forceinline__ void attn_item(LAS unsigned char* lds, bf16_t* qkvg, const float* sink8, int item, int nbs, const AttnKV& kvr) {
    const int tid = opaque_tid(), lane = tid & 63, w = tid >> 6, g = lane >> 4, li = lane & 15, qq = li >> 2, pp = li & 3;
    const int bi = item >> 1, hk = item & 1, bis = bi & (nbs - 1), row0 = bi * 128;
    const bool has_prev = bis > 0, has_next = bis < nbs - 1;
    LAS unsigned char* Kl = lds; LAS unsigned char* Vl = lds + 384 * AP;
#pragma unroll
    for (int i = 0; i < 6; ++i) {
        const int c = tid + 512 * i, r = c >> 3, ch = c & 7;
        *(LAS u32x4*)(Kl + r * AP + ch * 16) = kvr.k[i]; *(LAS u32x4*)(Vl + r * AP + ch * 16) = kvr.v[i];
    }
    __syncthreads();
    const int head = hk * 4 + (w >> 1);
    const float sink = sink8[head] * 1.4426950408889634f;
    const unsigned vaddr0 = lds_addr(Vl) + (unsigned)((4 * g + qq) * AP + pp * 8);
#pragma unroll 1
    for (int pass = 0; pass < 4; ++pass) {
        const int qr0 = (w & 1) * 64 + pass * 16, r = qr0 + li;
        bf16_t* qp = qkvg + (size_t)(row0 + r) * QW + head * 64;
        const bf16x8 qf0 = *(const bf16x8*)(qp + 8 * g), qf1 = *(const bf16x8*)(qp + 32 + 8 * g);
        const int qt = qr0 >> 4;
        f32x4 st[24];
#pragma unroll
        for (int kt = 0; kt < 24; ++kt) {
            f32x4 a = (f32x4){0.f, 0.f, 0.f, 0.f};
            if (!((kt < 8 && kt < qt) || (kt >= 16 && kt - 16 > qt))) {
                LAS unsigned char* kp = Kl + (16 * kt + li) * AP + g * 16;
                a = mfma16(*(const LAS bf16x8*)kp, qf0, a); a = mfma16(*(const LAS bf16x8*)(kp + 64), qf1, a);
            }
            st[kt] = a;
        }
        float mx = sink;
#pragma unroll
        for (int kt = 0; kt < 24; ++kt)
#pragma unroll
            for (int j = 0; j < 4; ++j) {
                const int c = (16 * kt + 4 * g + j) & 127;
                const bool ok = (kt >= 8 && kt < 16) ? true : (kt < 8 ? (has_prev && c >= r) : (has_next && c <= r));
                st[kt][j] = ok ? st[kt][j] : -1e30f;
            }
#pragma unroll
        for (int kt = 0; kt < 24; ++kt) { mx = fmaxf(fmaxf(mx, st[kt][0]), st[kt][1]); mx = fmaxf(fmaxf(mx, st[kt][2]), st[kt][3]); }
        mx = fmaxf(mx, __shfl_xor(mx, 16)); mx = fmaxf(mx, __shfl_xor(mx, 32));
        float sum = 0.f;
#pragma unroll
        for (int kt = 0; kt < 24; ++kt)
#pragma unroll
            for (int j = 0; j < 4; ++j) { const float p = __builtin_amdgcn_exp2f(st[kt][j] - mx); st[kt][j] = p; sum += p; }
        sum += __shfl_xor(sum, 16); sum += __shfl_xor(sum, 32);
        const float inv = 1.0f / (sum + __builtin_amdgcn_exp2f(sink - mx));
        f32x4 o[4];
#pragma unroll
        for (int dt = 0; dt < 4; ++dt) o[dt] = (f32x4){0.f, 0.f, 0.f, 0.f};
#pragma unroll
        for (int ks = 0; ks < 12; ++ks) {
            if ((ks < 4 && 2 * ks + 1 < qt) || (ks >= 8 && 2 * ks - 16 > qt)) continue;
            s16x4 tr[8];
            const unsigned addr = vaddr0 + (unsigned)(ks * 32 * AP);
            TR8(addr, 0, 32, 64, 96, 2304, 2336, 2368, 2400, tr);
            const bf16x8 pf = pack8(st[2 * ks], st[2 * ks + 1]);
#pragma unroll
            for (int dt = 0; dt < 4; ++dt) o[dt] = mfma16(cat4(tr[dt], tr[4 + dt]), pf, o[dt]);
        }
#pragma unroll
        for (int dt = 0; dt < 4; ++dt) {
            u32x2 wv; wv.x = cvt_pk_bf16(o[dt][0] * inv, o[dt][1] * inv); wv.y = cvt_pk_bf16(o[dt][2] * inv, o[dt][3] * inv);
            *(u32x2*)(qp + 16 * dt + 4 * g) = wv;
        }
    }
    __syncthreads();
}

constexpr int RP = 272;
constexpr int RT = 128 * RP;
struct StateKV { u32x4 k[4], v[4]; };
__device__ __forceinline__ void ret_state_load(StateKV& r, const bf16_t* qkvg, int item) {
    const int tid = opaque_tid(), cgi = item >> 2, h = item & 3, row0 = cgi * 128;
#pragma unroll
    for (int i = 0; i < 4; ++i) {
        const int c = tid + 512 * i, rr = c >> 4, ch = c & 15;
        const bf16_t* p = qkvg + (size_t)(row0 + rr) * QW + 1280 + h * 128 + ch * 8;
        r.k[i] = *(const u32x4*)p; r.v[i] = *(const u32x4*)(p + 512);
    }
}
__device__ __forceinline__ void ret_state_item(LAS unsigned char* lds, const bf16_t* qkvg, bf16_t* SF, bf16_t* SB, const float* lgf, const float* lgb, int item, const StateKV& kvr) {
    const int tid = opaque_tid(), lane = tid & 63, w = tid >> 6, g = lane >> 4, li = lane & 15, qq = li >> 2, pp = li & 3;
    const int cgi = item >> 2, h = item & 3;
    const float lf2 = lgf[h] * 1.4426950408889634f, lb2 = lgb[h] * 1.4426950408889634f;
    LAS unsigned char* Kf = lds; LAS unsigned char* Kb = lds + RT; LAS unsigned char* Vl = lds + 2 * RT;
#pragma unroll
    for (int i = 0; i < 4; ++i) {
        const int c = tid + 512 * i, r = c >> 4, ch = c & 15;
        const u32x4 kr = kvr.k[i], vr = kvr.v[i];
        const float zf = exp2f(lf2 * (float)(127 - r)), zb = exp2f(lb2 * (float)r);
        u32x4 kf, kb;
        kf.x = cvt_pk_bf16(bf_lo(kr.x) * zf, bf_hi(kr.x) * zf); kf.y = cvt_pk_bf16(bf_lo(kr.y) * zf, bf_hi(kr.y) * zf); kf.z = cvt_pk_bf16(bf_lo(kr.z) * zf, bf_hi(kr.z) * zf); kf.w = cvt_pk_bf16(bf_lo(kr.w) * zf, bf_hi(kr.w) * zf);
        kb.x = cvt_pk_bf16(bf_lo(kr.x) * zb, bf_hi(kr.x) * zb); kb.y = cvt_pk_bf16(bf_lo(kr.y) * zb, bf_hi(kr.y) * zb); kb.z = cvt_pk_bf16(bf_lo(kr.z) * zb, bf_hi(kr.z) * zb); kb.w = cvt_pk_bf16(bf_lo(kr.w) * zb, bf_hi(kr.w) * zb);
        *(LAS u32x4*)(Kf + r * RP + ch * 16) = kf; *(LAS u32x4*)(Kb + r * RP + ch * 16) = kb; *(LAS u32x4*)(Vl + r * RP + ch * 16) = vr;
    }
    __syncthreads();
    const unsigned lane_off = (unsigned)((8 * g + qq) * RP + pp * 8);
    s16x4 tv[8];
    { const unsigned a = lds_addr(Vl) + lane_off + (unsigned)(w * 32); TR8(a, 0, 8704, 17408, 26112, 1088, 9792, 18496, 27200, tv); }
    bf16x8 vf[4];
#pragma unroll
    for (int ks = 0; ks < 4; ++ks) vf[ks] = cat4(tv[ks], tv[4 + ks]);
#pragma unroll
    for (int dir = 0; dir < 2; ++dir) {
        bf16_t* ST = (dir ? SB : SF) + ((size_t)(cgi * 4 + h) * 128 + 16 * w + li) * 128 + 4 * g;
        const unsigned kbase = lds_addr(dir ? Kb : Kf) + lane_off;
#pragma unroll
        for (int dt = 0; dt < 8; ++dt) {
            s16x4 ta[8];
            const unsigned a = kbase + (unsigned)(dt * 32);
            TR8(a, 0, 8704, 17408, 26112, 1088, 9792, 18496, 27200, ta);
            f32x4 acc = (f32x4){0.f, 0.f, 0.f, 0.f};
#pragma unroll
            for (int ks = 0; ks < 4; ++ks) acc = mfma16(cat4(ta[ks], ta[4 + ks]), vf[ks], acc);
            u32x2 wv; wv.x = cvt_pk_bf16(acc[0], acc[1]); wv.y = cvt_pk_bf16(acc[2], acc[3]);
            *(u32x2*)(ST + 16 * dt) = wv;
        }
    }
    __syncthreads();
}

__device__ __forceinline__ void ret_scan(bf16_t* SF, bf16_t* SB, const float* lgf, const float* lgb, int nseq, int ncs, int gtid, int gthreads) {
    const int total = nseq * 4 * 2 * 4096;
    for (int idx = gtid; idx < total; idx += gthreads) {
        const int e4 = idx & 4095, dir = (idx >> 12) & 1, h = (idx >> 13) & 3, seq = idx >> 15;
        const float dec = __expf((dir ? lgb[h] : lgf[h]) * 128.0f);
        bf16_t* base = (dir ? SB : SF) + (size_t)h * 16384 + (size_t)e4 * 4;
        const int c0 = seq * ncs;
        float r0 = 0.f, r1 = 0.f, r2 = 0.f, r3 = 0.f;
        for (int cb = 0; cb < ncs; cb += 8) {
            u32x2 kv[8];
#pragma unroll
            for (int j = 0; j < 8; ++j) { const int c = dir ? (ncs - 1 - (cb + j)) : (cb + j); kv[j] = *(const u32x2*)(base + (size_t)(c0 + c) * 65536); }
#pragma unroll
            for (int j = 0; j < 8; ++j) { const int c = dir ? (ncs - 1 - (cb + j)) : (cb + j);
                u32x2 o; o.x = cvt_pk_bf16(r0, r1); o.y = cvt_pk_bf16(r2, r3);
                *(u32x2*)(base + (size_t)(c0 + c) * 65536) = o;
                r0 = r0 * dec + bf_lo(kv[j].x); r1 = r1 * dec + bf_hi(kv[j].x); r2 = r2 * dec + bf_lo(kv[j].y); r3 = r3 * dec + bf_hi(kv[j].y); }
        }
    }
}

__device__ __forceinline__ void ret_out_item(LAS unsigned char* lds, bf16_t* qkvg, const bf16_t* SF, const bf16_t* SB, const float* lgf, const float* lgb, const float* normg, int item) {
    const int tid = opaque_tid(), lane = tid & 63, w = tid >> 6, g = lane >> 4, li = lane & 15, qq = li >> 2, pp = li & 3;
    const int cgi = item >> 2, h = item & 3, row0 = cgi * 128;
    const float lf2 = lgf[h] * 1.4426950408889634f, lb2 = lgb[h] * 1.4426950408889634f;
    LAS unsigned char* Kl = lds; LAS unsigned char* Vl = lds + RT; LAS unsigned char* Rf = lds + 2 * RT; LAS unsigned char* Rb = lds + 3 * RT;
#pragma unroll
    for (int i = 0; i < 4; ++i) {
        const int c = tid + 512 * i, r = c >> 4, ch = c & 15;
        const bf16_t* p = qkvg + (size_t)(row0 + r) * QW + 1280 + h * 128 + ch * 8;
        const size_t so = ((size_t)(cgi * 4 + h) * 128 + r) * 128 + ch * 8;
        const u32x4 kr = *(const u32x4*)p, vr = *(const u32x4*)(p + 512), rf = *(const u32x4*)(SF + so), rb = *(const u32x4*)(SB + so);
        *(LAS u32x4*)(Kl + r * RP + ch * 16) = kr; *(LAS u32x4*)(Vl + r * RP + ch * 16) = vr; *(LAS u32x4*)(Rf + r * RP + ch * 16) = rf; *(LAS u32x4*)(Rb + r * RP + ch * 16) = rb;
    }
    const int n = 16 * w + li;
    bf16_t* qp = qkvg + (size_t)(row0 + n) * QW + 768 + h * 128;
    bf16x8 qf[4];
#pragma unroll
    for (int s = 0; s < 4; ++s) qf[s] = *(const bf16x8*)(qp + 32 * s + 8 * g);
    __syncthreads();
    f32x4 st[8];
#pragma unroll
    for (int kt = 0; kt < 8; ++kt) {
        LAS unsigned char* kp = Kl + (16 * kt + li) * RP + g * 16;
        f32x4 a = (f32x4){0.f, 0.f, 0.f, 0.f};
#pragma unroll
        for (int s = 0; s < 4; ++s) a = mfma16(*(const LAS bf16x8*)(kp + 64 * s), qf[s], a);
#pragma unroll
        for (int j = 0; j < 4; ++j) { const int dl = n - (16 * kt + 4 * g + j); a[j] *= exp2f(dl >= 0 ? lf2 * (float)dl : -lb2 * (float)dl); }
        st[kt] = a;
    }
    f32x4 o[8], of[8], ob[8];
#pragma unroll
    for (int et = 0; et < 8; ++et) { o[et] = (f32x4){0.f, 0.f, 0.f, 0.f}; of[et] = o[et]; ob[et] = o[et]; }
    const unsigned vaddr0 = lds_addr(Vl) + (unsigned)((4 * g + qq) * RP + pp * 8);
#pragma unroll
    for (int ks = 0; ks < 4; ++ks) {
        s16x4 t0[8], t1[8];
        const unsigned addr = vaddr0 + (unsigned)(ks * 32 * RP);
        TR8(addr, 0, 32, 64, 96, 4352, 4384, 4416, 4448, t0);
        TR8(addr, 128, 160, 192, 224, 4480, 4512, 4544, 4576, t1);
        const bf16x8 pf = pack8(st[2 * ks], st[2 * ks + 1]);
#pragma unroll
        for (int et = 0; et < 4; ++et) { o[et] = mfma16(cat4(t0[et], t0[4 + et]), pf, o[et]); o[4 + et] = mfma16(cat4(t1[et], t1[4 + et]), pf, o[4 + et]); }
    }
#pragma unroll
    for (int et = 0; et < 8; ++et) {
        LAS unsigned char* fp = Rf + (16 * et + li) * RP + g * 16; LAS unsigned char* bp = Rb + (16 * et + li) * RP + g * 16;
#pragma unroll
        for (int s = 0; s < 4; ++s) { of[et] = mfma16(*(const LAS bf16x8*)(fp + 64 * s), qf[s], of[et]); ob[et] = mfma16(*(const LAS bf16x8*)(bp + 64 * s), qf[s], ob[et]); }
    }
    const float xf = exp2f(lf2 * (float)(n + 1)), xb = exp2f(lb2 * (float)(128 - n));
    float ss = 0.f;
#pragma unroll
    for (int et = 0; et < 8; ++et)
#pragma unroll
        for (int j = 0; j < 4; ++j) { const float v = o[et][j] + xf * of[et][j] + xb * ob[et][j]; o[et][j] = v; ss += v * v; }
    ss += __shfl_xor(ss, 16); ss += __shfl_xor(ss, 32);
    const float rinv = __builtin_amdgcn_rsqf(ss * (1.0f / 128.0f) + EPS);
#pragma unroll
    for (int et = 0; et < 8; ++et) {
        const int e0 = 16 * et + 4 * g;
        const u32x2 gr = *(const u32x2*)(qp + 1536 + e0);
        const f32x4 ng = *(const f32x4*)(normg + h * 128 + e0);
        const float g0 = bf_lo(gr.x), g1 = bf_hi(gr.x), g2 = bf_lo(gr.y), g3 = bf_hi(gr.y);
        const float v0 = o[et][0] * rinv * ng[0] * g0 * sigmoid_f(g0), v1 = o[et][1] * rinv * ng[1] * g1 * sigmoid_f(g1);
        const float v2 = o[et][2] * rinv * ng[2] * g2 * sigmoid_f(g2), v3 = o[et][3] * rinv * ng[3] * g3 * sigmoid_f(g3);
        u32x2 wv; wv.x = cvt_pk_bf16(v0, v1); wv.y = cvt_pk_bf16(v2, v3);
        *(u32x2*)(qp + e0) = wv;
    }
    __syncthreads();
}
struct Params {
    const float* x_prompt; const float* x_sample; const float* norm_mix_g; const float* w_in; const float* attn_sink; const float* lgf; const float* lgb; const float* ret_norm_g;
    const float* w_battn; const float* w_bret; const float* w_out; const float* norm_ffn_g; const float* w_ffn_in; const float* conv_w; const float* conv_b; const float* w_ffn_out; const float* final_g;
    float* out; unsigned char* ws;
};

__device__ __forceinline__ void transpose_item(const float* W, int K, int N, const float* gain, bf16_t* WT, int k0, int nsrc0, int prow0, LAS float* scr, int lane) {
    const int kr = lane >> 3, c4 = (lane & 7) * 4;
    f32x4 v[8];
#pragma unroll
    for (int i = 0; i < 8; ++i) v[i] = *(const f32x4*)(W + (size_t)(k0 + kr + 8 * i) * N + nsrc0 + c4);
#pragma unroll
    for (int i = 0; i < 8; ++i) { const float gsc = gain ? gain[k0 + kr + 8 * i] : 1.0f; LAS float* d = scr + (kr + 8 * i) * 33 + c4;
        d[0] = v[i][0] * gsc; d[1] = v[i][1] * gsc; d[2] = v[i][2] * gsc; d[3] = v[i][3] * gsc; }
    asm volatile("s_waitcnt lgkmcnt(0)" ::: "memory");
    const int c = lane & 7;
#pragma unroll
    for (int j = 0; j < 4; ++j) { const int n = (lane >> 3) + 8 * j; const LAS float* s = scr + (8 * c) * 33 + n;
        u32x4 o; o.x = cvt_pk_bf16(s[0 * 33], s[1 * 33]); o.y = cvt_pk_bf16(s[2 * 33], s[3 * 33]); o.z = cvt_pk_bf16(s[4 * 33], s[5 * 33]); o.w = cvt_pk_bf16(s[6 * 33], s[7 * 33]);
        *(u32x4*)(WT + (size_t)(prow0 + n) * K + k0 + 8 * c) = o; }
    asm volatile("s_waitcnt lgkmcnt(0)" ::: "memory");
}
__device__ __forceinline__ int win_src_col(int p0) {
    const int pn = p0 >> 8, p = p0 & 255, bj = p >> 7, j = p & 127;
    if (pn < 2) return 256 * pn + 64 * (j >> 5) + 32 * bj + (j & 31);
    if (pn == 2) return j < 64 ? 512 + 64 * (j >> 5) + 32 * bj + (j & 31) : 640 + 64 * bj + (j - 64);
    if (pn < 7) return 256 * pn + 128 * (j >> 6) + 64 * bj + (j & 63);
    return p0;
}
#if defined(__HIP_DEVICE_COMPILE__)
typedef const __attribute__((address_space(4))) Params* kparams_t;
__device__ __forceinline__ Params fresh_params() { kparams_t p = (kparams_t)__builtin_amdgcn_kernarg_segment_ptr(); asm volatile("" : "+s"(p)); return *p; }
#else
__device__ __forceinline__ Params fresh_params() { return Params{}; }
#endif
constexpr int I_IN = 16 * (INW / 32), I_BR = 8 * 32, I_OUT = 16 * 32, I_F1 = 16 * (FF2 / 32), I_F2 = (FF / 64) * 32, I_L = I_IN + 2 * I_BR + I_OUT + I_F1 + I_F2;
__device__ __forceinline__ void convert_weights(const Params& P, LAS unsigned char* lds, int it_lo, int it_hi, int wrank, int wcount) {
    const int tid = opaque_tid(), lane = tid & 63, w = tid >> 6;
    LAS float* scr = (LAS float*)(lds + w * 8448);
    for (int it = it_lo + wrank; it < it_hi; it += wcount) {
        const int l = it / I_L; int r = it % I_L;
        if (r < I_IN) { const int kb = r / (INW / 32), nb = r % (INW / 32);
            transpose_item(P.w_in + (size_t)l * DM * INW, DM, INW, P.norm_mix_g + l * DM, (bf16_t*)(P.ws + WS_WIN + l * SZ_WIN), 64 * kb, win_src_col(32 * nb), 32 * nb, scr, lane); continue; } r -= I_IN;
        if (r < I_BR) { const int kb = r / 32, nb = r % 32;
            transpose_item(P.w_battn + (size_t)l * 512 * DM, 512, DM, nullptr, (bf16_t*)(P.ws + WS_WBR + l * SZ_WBR), 64 * kb, 32 * nb, 32 * nb, scr, lane); continue; } r -= I_BR;
        if (r < I_BR) { const int kb = r / 32, nb = r % 32;
            transpose_item(P.w_bret + (size_t)l * 512 * DM, 512, DM, nullptr, (bf16_t*)(P.ws + WS_WBR + l * SZ_WBR), 64 * kb, 32 * nb, 1024 + 32 * nb, scr, lane); continue; } r -= I_BR;
        if (r < I_OUT) { const int kb = r / 32, nb = r % 32;
            transpose_item(P.w_out + (size_t)l * DM * DM, DM, DM, nullptr, (bf16_t*)(P.ws + WS_WOUT + l * SZ_WOUT), 64 * kb, 32 * nb, 32 * nb, scr, lane); continue; } r -= I_OUT;
        if (r < I_F1) { const int kb = r / (FF2 / 32), nb = r % (FF2 / 32);
            const int p0 = 32 * nb;
            transpose_item(P.w_ffn_in + (size_t)l * DM * FF2, DM, FF2, P.norm_ffn_g + l * DM, (bf16_t*)(P.ws + WS_WF1 + l * SZ_WF1), 64 * kb, ((p0 >> 7) & 1) * FF + 128 * (p0 >> 8) + (p0 & 127), p0, scr, lane); continue; } r -= I_F1;
        { const int kb = r / 32, nb = r % 32;
            transpose_item(P.w_ffn_out + (size_t)l * FF * DM, FF, DM, nullptr, (bf16_t*)(P.ws + WS_WF2 + l * SZ_WF2), 64 * kb, 32 * nb, 32 * nb, scr, lane); }
    }
}
template <int NR> __device__ __forceinline__ void convert_rows(const Params& P, int row_lo, int row_hi, int wrank, int wcount) {
    const int lane = opaque_tid() & 63;
    for (int row = row_lo + NR * wrank; row < row_hi; row += NR * wcount) {
        f32x4 v[NR][4];
#pragma unroll
        for (int r = 0; r < NR; ++r) { const int rr = row + r; const float* xr = rr < SLAB ? P.x_prompt + (size_t)rr * DM : P.x_sample + (size_t)(rr - SLAB) * DM;
#pragma unroll
            for (int j = 0; j < 4; ++j) v[r][j] = *(const f32x4*)(xr + 256 * j + 4 * lane); }
#pragma unroll
        for (int r = 0; r < NR; ++r) {
            bf16_t* xb = (bf16_t*)(P.ws + WS_XB) + (size_t)(row + r) * DM;
            float s = 0.f;
#pragma unroll
            for (int j = 0; j < 4; ++j) { const f32x4 x = v[r][j]; s += (x[0] * x[0] + x[1] * x[1]) + (x[2] * x[2] + x[3] * x[3]);
                u32x2 o; o.x = cvt_pk_bf16(x[0], x[1]); o.y = cvt_pk_bf16(x[2], x[3]); *(u32x2*)(xb + 256 * j + 4 * lane) = o; }
#pragma unroll
            for (int o = 1; o < 64; o <<= 1) s += __shfl_xor(s, o);
            if (lane < 16) ((float*)(P.ws + WS_SSQ))[(size_t)(row + r) * 16 + lane] = lane == 0 ? s : 0.f;
        }
    }
}
__device__ __forceinline__ void prologue_phase(const Params& P, LAS unsigned char* lds) {
    const int tid = opaque_tid(), w = tid >> 6;
    const int gw = blockIdx.x * 8 + w, ngw = gridDim.x * 8;
    convert_weights(P, lds, 0, I_IN, gw, ngw);
    const int gt = blockIdx.x * 512 + tid, ngt = gridDim.x * 512;
    for (int idx = gt; idx < 8192 * 96; idx += ngt) {
        const int pos = idx / 96, t = idx % 96, half = t < 32 ? 32 : 64, i = t < 32 ? t : t - 32;
        const double freq = exp2(-(double)i / (double)half * 13.287712379549449);
        const double turns = (double)pos * freq * 0.15915494309189535;
        const float fr = (float)(turns - rint(turns));
        f32x2 cs; cs.x = cospif(2.0f * fr); cs.y = sinpif(2.0f * fr);
        f32x2* dst = t < 32 ? (f32x2*)(P.ws + WS_ROPEA) + (size_t)pos * 32 + i : (f32x2*)(P.ws + WS_ROPER) + (size_t)pos * 64 + i;
        *dst = cs;
    }
    convert_rows<4>(P, 0, SLAB, gw, ngw);
}
__device__ __forceinline__ bool idle_rank(int nwg, int G, int c, int& rank, int& count) {
    const int rem = nwg % G;
    if (rem == 0) { rank = c; count = G; return true; }
    rank = c - rem; count = G - rem; return c >= rem;
}

__device__ __forceinline__ void final_norm_rows(const Params& P, int row_lo, int row_hi, int gw, int ngw) {
    const int lane = opaque_tid() & 63;
    const float* ssq = (const float*)(P.ws + WS_SSQ); const bf16_t* xball = (const bf16_t*)(P.ws + WS_XB);
    f32x4 gv[4];
#pragma unroll
    for (int j = 0; j < 4; ++j) gv[j] = *(const f32x4*)(P.final_g + 256 * j + 4 * lane);
    for (int row = row_lo + 2 * gw; row < row_hi; row += 2 * ngw) {
        u32x2 q[2][4]; float sv[2];
#pragma unroll
        for (int r = 0; r < 2; ++r) {
#pragma unroll
            for (int j = 0; j < 4; ++j) q[r][j] = *(const u32x2*)(xball + (size_t)(row + r) * DM + 256 * j + 4 * lane);
            sv[r] = lane < 16 ? ssq[(size_t)(row + r) * 16 + lane] : 0.f;
        }
#pragma unroll
        for (int r = 0; r < 2; ++r) {
            float s = sv[r];
#pragma unroll
            for (int o = 1; o < 16; o <<= 1) s += __shfl_xor(s, o);
            s = __shfl(s, 0);
            const float rinv = __builtin_amdgcn_rsqf(s * (1.0f / 1024.0f) + EPS);
            float* xr = P.out + (size_t)(row + r) * DM;
#pragma unroll
            for (int j = 0; j < 4; ++j) { f32x4 v = (f32x4){bf_lo(q[r][j].x), bf_hi(q[r][j].x), bf_lo(q[r][j].y), bf_hi(q[r][j].y)}; v = v * rinv * gv[j]; *(f32x4*)(xr + 256 * j + 4 * lane) = v; }
        }
    }
}

#define XB_TMO      128
#define XB_XCNT(j)  (256  + 64 * (j))
#define XB_XSUB(j)  (1280 + 64 * (j))
#define XB_XGEN(j)  (2304 + 64 * (j))
#define XB_TOP      3328
#define XB_TOPGEN   3392
#define XCD_BAR_WORDS 3456
#define XB_SPIN_CAP (1u << 18)

__device__ __forceinline__ unsigned xb_ld(unsigned* p)              { return __hip_atomic_load(p, __ATOMIC_RELAXED, __HIP_MEMORY_SCOPE_AGENT); }
__device__ __forceinline__ unsigned xb_add(unsigned* p, unsigned v) { return __hip_atomic_fetch_add(p, v, __ATOMIC_RELAXED, __HIP_MEMORY_SCOPE_AGENT); }
__device__ __forceinline__ unsigned xb_xcc_id() { return (unsigned)__builtin_amdgcn_s_getreg((3 << 11) | 20) & 0xFu; }
#define XB_SPIN(cond, bar) do { unsigned _sp = 0; while (cond) { __builtin_amdgcn_s_sleep(1); \
    if ((++_sp & 255u) == 0u) { if (xb_ld(&(bar)[XB_TMO])) break; if (_sp > XB_SPIN_CAP) { atomicAdd(&(bar)[XB_TMO], 1u); break; } } } } while (0)

struct XcdBarrier {
    unsigned* bar; unsigned x;
    volatile LAS unsigned* st;
};

__device__ __forceinline__ XcdBarrier xcd_barrier_post(unsigned* bar, volatile LAS unsigned* st) {
    XcdBarrier b; b.bar = bar; b.x = xb_xcc_id(); b.st = st;
    if (threadIdx.x == 0) (void)xb_add(&bar[XB_XCNT(b.x)], 1u);
    return b;
}
__device__ __forceinline__ void xcd_barrier_complete(unsigned* bar, unsigned x, unsigned& nloc, unsigned& nx) {
    const unsigned G = gridDim.x * gridDim.y * gridDim.z;
    unsigned sum, cnt, mine, sp = 0u;
    for (;;) {
        sum = 0u; cnt = 0u; mine = 0u;
#pragma unroll
        for (unsigned j = 0; j < 16; ++j) { const unsigned c = xb_ld(&bar[XB_XCNT(j)]); sum += c; cnt += (c > 0u) ? 1u : 0u; mine = (j == x) ? c : mine; }
        if (sum == G) break;
        __builtin_amdgcn_s_sleep(1);
        if ((++sp & 255u) == 0u) { if (xb_ld(&bar[XB_TMO])) break; if (sp > XB_SPIN_CAP) { atomicAdd(&bar[XB_TMO], 1u); break; } }
    }
    nloc = mine > 0u ? mine : 1u; nx = cnt > 0u ? cnt : 1u;
}

__device__ __forceinline__ void xcd_barrier(const XcdBarrier& b) {
    asm volatile("s_waitcnt vmcnt(0)" ::: "memory");
    __syncthreads();
    if (threadIdx.x == 0) {
        unsigned* bar = b.bar;
        __builtin_amdgcn_s_waitcnt(0);
        unsigned nloc = b.st[0], nx = b.st[1];
        if (nloc == 0u) { xcd_barrier_complete(bar, b.x, nloc, nx); b.st[0] = nloc; b.st[1] = nx; }
        const unsigned old = xb_add(&bar[XB_XSUB(b.x)], 1u);
        const unsigned gen = old / nloc;
        if (old + 1u == (gen + 1u) * nloc) {
            __builtin_amdgcn_fence(__ATOMIC_RELEASE, "agent");
            asm volatile("s_waitcnt vmcnt(0)" ::: "memory");
            const unsigned og = xb_add(&bar[XB_TOP], 1u);
            const unsigned tg = og / nx;
            if (og + 1u == (tg + 1u) * nx) xb_add(&bar[XB_TOPGEN], 1u);
            else XB_SPIN(xb_ld(&bar[XB_TOPGEN]) == tg, bar);
            __builtin_amdgcn_fence(__ATOMIC_ACQUIRE, "agent");
            xb_add(&bar[XB_XGEN(b.x)], 1u);
            asm volatile("s_waitcnt vmcnt(0)" ::: "memory");
        } else {
            XB_SPIN(xb_ld(&bar[XB_XGEN(b.x)]) == gen, bar);
            __builtin_amdgcn_fence(__ATOMIC_ACQUIRE, "agent");
            asm volatile("s_waitcnt vmcnt(0)" ::: "memory");
        }
    }
    __syncthreads();
}


#define GSYNC() xcd_barrier(gbar)
__global__ __launch_bounds__(512, 2) void fwd_megakernel(Params P) {
    extern __shared__ __attribute__((aligned(16))) unsigned char shm[];
    LAS unsigned char* lds = (LAS unsigned char*)shm;
    cg::grid_group grid = cg::this_grid();
    const int G = gridDim.x, c = blockIdx.x;
    volatile LAS unsigned* xst = (volatile LAS unsigned*)(lds + LDS_BYTES - 16);
    if (threadIdx.x == 0) { xst[0] = 0u; xst[1] = 0u; }
    __syncthreads();
    const XcdBarrier gbar = xcd_barrier_post((unsigned*)(P.ws + WS_BAR), xst);
    prologue_phase(fresh_params(), lds);
    grid.sync();
#pragma unroll 1
    for (int l = 0; l < DEPTH; ++l) {
#pragma unroll 1
        for (int s = 0; s < NSLAB; ++s) {
#define SLAB_PTRS const Params Q = fresh_params(); const size_t r0 = (size_t)s * SLAB; unsigned char* SLB = Q.ws + WS_SLAB; \
            bf16_t* xb = (bf16_t*)(Q.ws + WS_XB) + r0 * DM; float* ssq = (float*)(Q.ws + WS_SSQ) + r0 * 16; float* xo = Q.out + r0 * DM; \
            bf16_t* qkvg = (bf16_t*)(SLB + SL_QKVG); bf16_t* gates = (bf16_t*)(SLB + SL_GATES); bf16_t* SF = (bf16_t*)(SLB + SL_SF); bf16_t* SB = (bf16_t*)(SLB + SL_SB); \
            bf16_t* merged = (bf16_t*)(SLB + SL_MERGED); bf16_t* act = (bf16_t*)(SLB + SL_ACT); \
            (void)xb; (void)ssq; (void)xo; (void)qkvg; (void)gates; (void)SF; (void)SB; (void)merged; (void)act
            {
                SLAB_PTRS;
                pg8::Gemm g{xb, xb, (const bf16_t*)(Q.ws + WS_WIN + l * SZ_WIN), DM, DM, DM};
                pg8::StaticOrder S; S.init(SLAB, INW, G, c);
                EpiProj E{qkvg, gates, ssq, (const f32x4*)(Q.ws + WS_ROPEA), (const f32x4*)(Q.ws + WS_ROPER), s == 0 ? 2047 : 8191};
                pg8::gemm_phase(lds, g, S, E);
                if (l == 0 && s < 2) { int rk, cnt;
                    if (idle_rank(S.nwg, G, c, rk, cnt)) { const Params PF = fresh_params(); const int wr_ = rk * 8 + (opaque_tid() >> 6), wc_ = cnt * 8;
                        if (s == 0) convert_weights(PF, lds, I_IN, I_L - I_F2, wr_, wc_); else convert_rows<2>(PF, 2 * SLAB, T_ALL, wr_, wc_); } }
            }
            GSYNC();
            {
                SLAB_PTRS;
                const int nbs = s == 0 ? 16 : 64;
                for (int a0 = c; a0 < 256; a0 += G) {
                    const int a = G == 256 ? (((a0 & 7) * 16 + (a0 >> 4)) * 2 + ((a0 >> 3) & 1)) : a0;
                    StateKV k0, k1; AttnKV k2;
                    ret_state_load(k0, qkvg, a);
                    ret_state_load(k1, qkvg, a + 256);
                    ret_state_item(lds, qkvg, SF, SB, Q.lgf + l * 4, Q.lgb + l * 4, a, k0);
                    attn_load(k2, qkvg, a, nbs);
                    ret_state_item(lds, qkvg, SF, SB, Q.lgf + l * 4, Q.lgb + l * 4, a + 256, k1);
                    attn_item(lds, qkvg, Q.attn_sink + l * 8, a, nbs, k2);
                }
            }
            GSYNC();
            {
                SLAB_PTRS;
                ret_scan(SF, SB, Q.lgf + l * 4, Q.lgb + l * 4, s == 0 ? 8 : 2, s == 0 ? 16 : 64, c * 512 + opaque_tid(), G * 512);
            }
            GSYNC();
            {
                SLAB_PTRS;
                for (int it = c; it < 512; it += G) ret_out_item(lds, qkvg, SF, SB, Q.lgf + l * 4, Q.lgb + l * 4, Q.ret_norm_g + l * 512, it);
            }
            GSYNC();
            {
                SLAB_PTRS;
                pg8::Gemm g{qkvg, qkvg + 768, (const bf16_t*)(Q.ws + WS_WBR + l * SZ_WBR), 512, QW, 512};
                pg8::MergeOrder S; S.init(SLAB, G, c);
                EpiMerge E{merged, gates};
                pg8::gemm_phase(lds, g, S, E);
            }
            GSYNC();
            {
                SLAB_PTRS;
                pg8::Gemm g{merged, merged, (const bf16_t*)(Q.ws + WS_WOUT + l * SZ_WOUT), DM, DM, DM};
                pg8::StaticOrder S; S.init(SLAB, DM, G, c);
                if (l == 0) { EpiResid<true> E{s == 0 ? Q.x_prompt : Q.x_sample + (size_t)(s - 1) * SLAB * DM, xb, ssq}; pg8::gemm_phase(lds, g, S, E); }
                else { EpiResid<false> E{nullptr, xb, ssq}; pg8::gemm_phase(lds, g, S, E); }
            }
            GSYNC();
            {
                SLAB_PTRS;
                pg8::Gemm g{xb, xb, (const bf16_t*)(Q.ws + WS_WF1 + l * SZ_WF1), DM, DM, DM};
                pg8::FfnOrder S4; S4.init(65, FF2, G, c);
                EpiFfnConv E{act, ssq, Q.conv_w + (size_t)l * 3 * FF, Q.conv_b + (size_t)l * FF, (LAS float*)(lds + 131072), s == 0 ? 2048 : 8192};
                pg8::gemm_phase(lds, g, S4, E);
                if (l == 0 && s < 2) { int rk, cnt;
                    if (idle_rank(S4.so.nwg, G, c, rk, cnt)) { const Params PF = fresh_params(); const int wr_ = rk * 8 + (opaque_tid() >> 6), wc_ = cnt * 8;
                        if (s == 0) { convert_weights(PF, lds, I_L - I_F2, I_L + I_IN, wr_, wc_); convert_rows<2>(PF, SLAB, 2 * SLAB, wr_, wc_); }
                        else convert_weights(PF, lds, I_L + I_IN, 2 * I_L, wr_, wc_); } }
                if (l == DEPTH - 1 && s >= 1) { int rk, cnt;
                    if (idle_rank(S4.so.nwg, G, c, rk, cnt)) final_norm_rows(fresh_params(), (s - 1) * SLAB, s * SLAB, rk * 8 + (opaque_tid() >> 6), cnt * 8); }
            }
            GSYNC();
            {
                SLAB_PTRS;
                pg8::Gemm g{act, act, (const bf16_t*)(Q.ws + WS_WF2 + l * SZ_WF2), FF, FF, FF};
                pg8::StaticOrder S; S.init(SLAB, DM, G, c);
                EpiResid<false> E{nullptr, xb, ssq};
                pg8::gemm_phase(lds, g, S, E);
            }
            GSYNC();
#undef SLAB_PTRS
        }
    }
    final_norm_rows(fresh_params(), 2 * SLAB, T_ALL, c * 8 + (opaque_tid() >> 6), G * 8);
}

extern "C" void kernel_launch(void* const* d_in, const int* in_sizes, int n_in, void* d_out, int out_size, void* d_ws, size_t ws_size, hipStream_t stream) {
    static int grid_blocks = 0;
    if (!grid_blocks) {
        int dev = 0, cus = 0, per_cu = 0;
        hipGetDevice(&dev);
        hipDeviceGetAttribute(&cus, hipDeviceAttributeMultiprocessorCount, dev);
        hipFuncSetAttribute((const void*)fwd_megakernel, hipFuncAttributeMaxDynamicSharedMemorySize, LDS_BYTES);
        hipOccupancyMaxActiveBlocksPerMultiprocessor(&per_cu, (const void*)fwd_megakernel, 512, LDS_BYTES);
        if (per_cu < 1) per_cu = 1;
        grid_blocks = cus * per_cu;
        if (ws_size < WS_END) fprintf(stderr, "workspace too small: %zu < %zu\n", ws_size, (size_t)WS_END);
    }
    if (hipMemsetAsync((unsigned char*)d_ws + WS_BAR, 0, 16384, stream) != hipSuccess) fprintf(stderr, "memset of the barrier words failed\n");
    Params p{};
    p.x_prompt = (const float*)d_in[0]; p.x_sample = (const float*)d_in[1]; p.norm_mix_g = (const float*)d_in[2]; p.w_in = (const float*)d_in[3]; p.attn_sink = (const float*)d_in[4];
    p.lgf = (const float*)d_in[5]; p.lgb = (const float*)d_in[6]; p.ret_norm_g = (const float*)d_in[7]; p.w_battn = (const float*)d_in[8]; p.w_bret = (const float*)d_in[9]; p.w_out = (const float*)d_in[10];
    p.norm_ffn_g = (const float*)d_in[11]; p.w_ffn_in = (const float*)d_in[12]; p.conv_w = (const float*)d_in[13]; p.conv_b = (const float*)d_in[14]; p.w_ffn_out = (const float*)d_in[15]; p.final_g = (const float*)d_in[16];
    p.out = (float*)d_out; p.ws = (unsigned char*)d_ws;
    void* args[] = {&p};
    hipError_t e = hipLaunchCooperativeKernel((const void*)fwd_megakernel, dim3(grid_blocks), dim3(512), args, LDS_BYTES, stream);
    if (e != hipSuccess) fprintf(stderr, "cooperative launch failed: %s (grid %d)\n", hipGetErrorString(e), grid_blocks);
}
```

```cpp
#include <hip/hip_runtime.h>
#include <hip/hip_cooperative_groups.h>
#include <cstdio>
namespace cg = cooperative_groups;

#define LAS __attribute__((address_space(3)))
typedef unsigned short bf16_t;
typedef short bf16x8 __attribute__((ext_vector_type(8)));
typedef short s16x4 __attribute__((ext_vector_type(4)));
typedef float f32x4 __attribute__((ext_vector_type(4)));
typedef float f32x2 __attribute__((ext_vector_type(2)));
typedef unsigned u32x4 __attribute__((ext_vector_type(4)));
typedef unsigned u32x2 __attribute__((ext_vector_type(2)));

constexpr int T_ALL = 49152, SLAB = 16384, NSLAB = 3, DM = 1024, INW = 4864, QW = 2816, GW = 2048, FF = 2816, FF2 = 5632, DEPTH = 2;
constexpr int LDS_BYTES = 147456;
constexpr float EPS = 1e-6f;
constexpr size_t SZ_WIN = (size_t)INW * DM * 2, SZ_WBR = (size_t)2048 * 512 * 2, SZ_WOUT = (size_t)DM * DM * 2, SZ_WF1 = (size_t)FF2 * DM * 2, SZ_WF2 = (size_t)DM * FF * 2;
constexpr size_t WS_WIN = 0;
constexpr size_t WS_WBR = WS_WIN + DEPTH * SZ_WIN;
constexpr size_t WS_WOUT = WS_WBR + DEPTH * SZ_WBR;
constexpr size_t WS_WF1 = WS_WOUT + DEPTH * SZ_WOUT;
constexpr size_t WS_WF2 = WS_WF1 + DEPTH * SZ_WF1;
constexpr size_t WS_ROPEA = WS_WF2 + DEPTH * SZ_WF2;
constexpr size_t WS_ROPER = WS_ROPEA + (size_t)8192 * 32 * 8;
constexpr size_t WS_SSQ = WS_ROPER + (size_t)8192 * 64 * 8;
constexpr size_t WS_XB = WS_SSQ + (size_t)T_ALL * 16 * 4;
constexpr size_t WS_SLAB = WS_XB + (size_t)T_ALL * DM * 2;
constexpr size_t SL_QKVG = 0;
constexpr size_t SL_GATES = SL_QKVG + (size_t)SLAB * QW * 2;
constexpr size_t SL_SF = SL_GATES + (size_t)SLAB * GW * 2;
constexpr size_t SL_SB = SL_SF + (size_t)128 * 4 * 16384 * 2;
constexpr size_t SL_MERGED = SL_SB + (size_t)128 * 4 * 16384 * 2;
constexpr size_t SL_ACT = 0;
constexpr size_t WS_BAR = WS_SLAB + SL_MERGED + (size_t)SLAB * DM * 2;
constexpr size_t WS_END = WS_BAR + 16384;

__device__ __forceinline__ int opaque_tid() { int t = threadIdx.x; asm volatile("" : "+v"(t)); return t; }
typedef __bf16 bf16x2_t __attribute__((ext_vector_type(2)));
__device__ __forceinline__ unsigned cvt_pk_bf16(float lo, float hi) { f32x2 v; v.x = lo; v.y = hi; return __builtin_bit_cast(unsigned, __builtin_convertvector(v, bf16x2_t)); }
__device__ __forceinline__ float bf_lo(unsigned u) { return __uint_as_float(u << 16); }
__device__ __forceinline__ float bf_hi(unsigned u) { return __uint_as_float(u & 0xffff0000u); }
__device__ __forceinline__ f32x4 mfma16(bf16x8 a, bf16x8 b, f32x4 c) { return __builtin_amdgcn_mfma_f32_16x16x32_bf16(a, b, c, 0, 0, 0); }

#define PG8_LAS LAS
namespace pg8 {
constexpr int BM = 256, BK = 64, HALF = 128, HTB = HALF * BK * 2  , STAGE_BYTES = 8 * HTB, NXCD = 8, WGM = 8;
__host__ __device__ __forceinline__ int lds_byte(int r, int c) { const int st = (r >> 4) * 2 + (c >> 5), rr = r & 15, cc = c & 31, ob = rr * 64 + cc * 2; return st * 1024 + (ob ^ (((ob >> 9) & 1) << 5)); }
__host__ __device__ __forceinline__ void stage_rc(int b, int& R, int& C) { const int st = b / 1024, sb = b % 1024, swz = sb ^ (((sb >> 9) & 1) << 5); R = (st >> 1) * 16 + swz / 64; C = (st & 1) * 32 + (swz % 64) / 2; }
__host__ __device__ __forceinline__ int perm32(int rho) { const int n = rho >> 4, i = rho & 15; return 8 * (i >> 2) + 4 * n + (i & 3); }

struct Unit { int pm, pn, asel, arow; };
struct Gemm { const bf16_t* A; const bf16_t* A2; const bf16_t* Bt; int K, lda, ldb; };

struct StaticOrder {
    int nM, nN, nwg, G, c;
    __device__ void init(int M, int N, int G_, int c_) { nM = M / BM; nN = N / BM; nwg = nM * nN; G = G_; c = c_; }
    __device__ bool next(int i, Unit& u) const {
        const long L = (long)i * G + c; if (L >= nwg) return false;
        int wgid = (int)L; { const int q = nwg / NXCD, r = nwg % NXCD, xcd = wgid % NXCD, off = wgid / NXCD; wgid = (xcd < r ? xcd * (q + 1) : r * (q + 1) + (xcd - r) * q) + off; }
        const int nig = WGM * nN, gid = wgid / nig, fm = gid * WGM, gsz = (nM - fm) < WGM ? (nM - fm) : WGM;
        u.pm = fm + ((wgid % nig) % gsz); u.pn = (wgid % nig) / gsz; u.asel = 0; u.arow = u.pm * BM; return true;
    }
};
struct MergeOrder {
    int ntile, G, c;
    __device__ void init(int M, int G_, int c_) { ntile = (M / BM) * 4; G = G_; c = c_; }
    __device__ bool next(int i, Unit& u) const {
        const long t = (long)(i >> 1) * G + c; if (t >= ntile) return false;
        u.pm = (int)(t >> 2); u.asel = i & 1; u.pn = (int)(t & 3) + 4 * u.asel; u.arow = u.pm * BM; return true;
    }
};

struct FfnOrder {
    StaticOrder so;
    __device__ void init(int nMt, int N, int G_, int c_) { so.init(nMt * BM, N, G_, c_); }
    __device__ bool next(int i, Unit& u) const {
        if (!so.next(i, u)) return false;
        u.arow = 254 * u.pm - 1; return true;
    }
};

template <class Epi, class Sched>
__device__ __forceinline__ void gemm_phase(PG8_LAS unsigned char* lds, const Gemm g, const Sched& S, const Epi& E) {
    const int tid = opaque_tid(), wid = __builtin_amdgcn_readfirstlane(tid >> 6), lane = tid & 63, wr = wid >> 2, wc = wid & 3, fr = lane & 15, fq = lane >> 4;
    const int K = g.K, nt = K / BK;
    unsigned voffA[2], voffB[2];
#pragma unroll
    for (int i = 0; i < 2; ++i) { int R, C; stage_rc(tid * 16 + i * 8192, R, C); const int Rb = Epi::PERM ? ((R & ~31) + perm32(R & 31)) : R;
        voffA[i] = (unsigned)(R * g.lda + C) * 2u; voffB[i] = (unsigned)(Rb * g.ldb + C) * 2u; }
    const size_t kstep = (size_t)(BK * 2);
    const size_t hstepA = (size_t)HALF * g.lda * 2, hstepB = (size_t)HALF * g.ldb * 2;
    const size_t tstepB = 2 * hstepB;
    const unsigned ldsw = (unsigned)wid * 1024u;
    const int aoff = lds_byte(wr * 64 + fr, fq * 8), boff = lds_byte(wc * 32 + fr, fq * 8);
#define PG8_SA(b, h) (((b) * 2 + (h)) * HTB)
#define PG8_SB(b, h) ((4 + (b) * 2 + (h)) * HTB)
#define PG8_STAGE(bufoff, gbase, voff) do { _Pragma("unroll") for (int _i = 0; _i < 2; ++_i) \
        __builtin_amdgcn_global_load_lds((const unsigned*)((const char*)(gbase) + (voff)[_i]), (PG8_LAS unsigned*)(lds + (bufoff) + ldsw + _i * 8192), 16, 0, 0); } while (0)
#define PG8_LDA(dst, b, h) do { _Pragma("unroll") for (int m = 0; m < 4; ++m) _Pragma("unroll") for (int k = 0; k < 2; ++k) dst[m][k] = *(const PG8_LAS bf16x8*)(lds + PG8_SA(b, h) + aoff + m * 2048 + k * 1024); } while (0)
#define PG8_LDB(dst, b, h) do { _Pragma("unroll") for (int n = 0; n < 2; ++n) _Pragma("unroll") for (int k = 0; k < 2; ++k) dst[n][k] = *(const PG8_LAS bf16x8*)(lds + PG8_SB(b, h) + boff + n * 2048 + k * 1024); } while (0)
#define PG8_MMA(ai, bj, At, Bt) do { __builtin_amdgcn_s_setprio(1); _Pragma("unroll") for (int m = 0; m < 4; ++m) _Pragma("unroll") for (int n = 0; n < 2; ++n) _Pragma("unroll") for (int k = 0; k < 2; ++k) \
        acc[ai][bj][m][n] = __builtin_amdgcn_mfma_f32_16x16x32_bf16(Bt[n][k], At[m][k], acc[ai][bj][m][n], 0, 0, 0); __builtin_amdgcn_s_setprio(0); } while (0)
#define PG8_WAIT_V(n) asm volatile("s_waitcnt vmcnt(" #n ")" ::: "memory")
#define PG8_WAIT_L(n) asm volatile("s_waitcnt lgkmcnt(" #n ")" ::: "memory")
#define PG8_BAR __builtin_amdgcn_s_barrier()
#define PG8_SCHED __builtin_amdgcn_sched_barrier(0)
    Unit cur, nxt; int ui = 0;
    if (!S.next(0, cur)) return;
    f32x4 acc[2][2][4][2];
#pragma unroll
    for (int a = 0; a < 2; ++a)
#pragma unroll
        for (int b = 0; b < 2; ++b)
#pragma unroll
            for (int m = 0; m < 4; ++m)
#pragma unroll
                for (int n = 0; n < 2; ++n) acc[a][b][m][n] = (f32x4){0.f, 0.f, 0.f, 0.f};
    bf16x8 At[4][2], B0[2][2], B1[2][2];
    const long rstepA = (long)g.lda * 2;
    const char* cA = (const char*)(cur.asel ? g.A2 : g.A) + (long)cur.arow * rstepA; const char* cB = (const char*)g.Bt + (size_t)cur.pn * tstepB;
    PG8_STAGE(PG8_SB(0, 0), cB, voffB); PG8_STAGE(PG8_SA(0, 0), cA, voffA); PG8_STAGE(PG8_SB(0, 1), cB + hstepB, voffB); PG8_STAGE(PG8_SA(0, 1), cA + hstepA, voffA);
    if (wr == 1) PG8_BAR;
    PG8_WAIT_V(4); PG8_BAR;
    PG8_STAGE(PG8_SB(1, 0), cB + kstep, voffB); PG8_STAGE(PG8_SA(1, 0), cA + kstep, voffA); PG8_STAGE(PG8_SB(1, 1), cB + hstepB + kstep, voffB);
    PG8_WAIT_V(6); PG8_BAR;
    for (;;) {
        const bool has_next = S.next(ui + 1, nxt);
        const char* nA = has_next ? (const char*)(nxt.asel ? g.A2 : g.A) + (long)nxt.arow * rstepA : cA; const char* nB = has_next ? (const char*)g.Bt + (size_t)nxt.pn * tstepB : cB;
        for (int t = 0; t < nt; t += 2) {
            const bool last = (t == nt - 2);
            const char* a1 = cA + (size_t)(t + 1) * kstep;
            const char* a2 = last ? nA : cA + (size_t)(t + 2) * kstep; const char* b2 = last ? nB : cB + (size_t)(t + 2) * kstep;
            const char* a3 = a2 + kstep; const char* b3 = b2 + kstep;
            PG8_LDB(B0, 0, 0); PG8_SCHED; PG8_LDA(At, 0, 0); PG8_STAGE(PG8_SA(1, 1), a1 + hstepA, voffA);
            PG8_WAIT_L(8); PG8_BAR; PG8_WAIT_L(0); PG8_MMA(0, 0, At, B0); PG8_BAR; PG8_SCHED;
            PG8_LDB(B1, 0, 1); PG8_STAGE(PG8_SB(0, 0), b2, voffB);
            PG8_BAR; PG8_WAIT_L(0); PG8_MMA(0, 1, At, B1); PG8_BAR;
            PG8_LDA(At, 0, 1); PG8_STAGE(PG8_SA(0, 0), a2, voffA);
            PG8_BAR; PG8_WAIT_L(0); PG8_MMA(1, 0, At, B0); PG8_BAR; PG8_SCHED;
            PG8_STAGE(PG8_SB(0, 1), b2 + hstepB, voffB);
            PG8_WAIT_V(6); PG8_BAR; PG8_MMA(1, 1, At, B1); PG8_BAR;
            PG8_LDB(B0, 1, 0); PG8_SCHED; PG8_LDA(At, 1, 0); PG8_STAGE(PG8_SA(0, 1), a2 + hstepA, voffA);
            PG8_WAIT_L(8); PG8_BAR; PG8_WAIT_L(0); PG8_MMA(0, 0, At, B0); PG8_BAR; PG8_SCHED;
            PG8_LDB(B1, 1, 1); PG8_STAGE(PG8_SB(1, 0), b3, voffB);
            PG8_BAR; PG8_WAIT_L(0); PG8_MMA(0, 1, At, B1); PG8_BAR;
            PG8_LDA(At, 1, 1); PG8_STAGE(PG8_SA(1, 0), a3, voffA);
            PG8_BAR; PG8_WAIT_L(0); PG8_MMA(1, 0, At, B0); PG8_BAR; PG8_SCHED;
            PG8_STAGE(PG8_SB(1, 1), b3 + hstepB, voffB);
            PG8_WAIT_V(6); PG8_BAR; PG8_MMA(1, 1, At, B1); PG8_BAR;
        }
        E(acc, cur, wr, wc, fr, fq);
        if (!has_next) break;
        if (!Epi::keep_acc(cur))
#pragma unroll
        for (int a = 0; a < 2; ++a)
#pragma unroll
            for (int b = 0; b < 2; ++b)
#pragma unroll
                for (int m = 0; m < 4; ++m)
#pragma unroll
                    for (int n = 0; n < 2; ++n) acc[a][b][m][n] = (f32x4){0.f, 0.f, 0.f, 0.f};
        cur = nxt; cA = nA; cB = nB; ++ui;
    }
    PG8_WAIT_V(0);
    if (wr == 0) PG8_BAR;
    PG8_BAR;
#undef PG8_SA
#undef PG8_SB
#undef PG8_STAGE
#undef PG8_LDA
#undef PG8_LDB
#undef PG8_MMA
#undef PG8_WAIT_V
#undef PG8_WAIT_L
#undef PG8_BAR
#undef PG8_SCHED
}
}

using pg8::Unit;
__device__ __forceinline__ float row_rinv(const float* ssq, int row, int fq) {
    const f32x4 p = *(const f32x4*)(ssq + (size_t)row * 16 + 4 * fq);
    float s = (p[0] + p[1]) + (p[2] + p[3]);
    s += __shfl_xor(s, 16); s += __shfl_xor(s, 32);
    return __builtin_amdgcn_rsqf(s * (1.0f / 1024.0f) + EPS);
}
__device__ __forceinline__ float sigmoid_f(float x) { return __builtin_amdgcn_rcpf(1.0f + __expf(-x)); }

__device__ __forceinline__ f32x2 gelu_pk(f32x2 v) {
    const f32x2 av = __builtin_elementwise_abs(v), d = av * 0.2316418882f + 1.0f;
    f32x2 t; t.x = __builtin_amdgcn_rcpf(d.x); t.y = __builtin_amdgcn_rcpf(d.y);
    f32x2 q = t * 0.5307027145f + (-0.7265760135f); q = q * t + 0.7107068705f; q = q * t + (-0.142248368f); q = q * t + 0.127414796f; q = q * t;
    const f32x2 s = (v * v) * (-0.72134752044f);
    f32x2 e; e.x = __builtin_amdgcn_exp2f(s.x); e.y = __builtin_amdgcn_exp2f(s.y);
    const f32x2 m = v * (q * e);
    f32x2 o; o.x = fmaxf(v.x, 0.f) - fabsf(m.x); o.y = fmaxf(v.y, 0.f) - fabsf(m.y); return o;
}

struct EpiProj {
    static constexpr bool PERM = true;
    static __device__ __forceinline__ bool keep_acc(const Unit&) { return false; }
    bf16_t* qkvg; bf16_t* gates; const float* ssq; const f32x4* ropeA; const f32x4* ropeR; int seqmask;
    __device__ __forceinline__ void operator()(f32x4 (&acc)[2][2][4][2], const Unit& u, int wr, int wc, int fr, int fq) const {
        const int pn = u.pn, rowb = u.pm * 256 + wr * 64 + fr;
        bf16_t* dst = qkvg; int ld = QW, col0, col1, tabw = 0, i0 = 0; bool rope = false, sigm = false; float scale = 1.0f; const f32x4* tab = ropeA;
        if (pn >= 11) { dst = gates; ld = GW; col0 = 256 * (pn - 11) + 32 * wc + 8 * fq; col1 = col0 + 128; sigm = true; scale = -1.4426950408889634f; }
        else if (pn >= 7) { col0 = 256 * pn + 32 * wc + 8 * fq; col1 = col0 + 128; }
        else if (pn >= 3) { rope = true; tab = ropeR; tabw = 64; i0 = 32 * (wc & 1) + 8 * fq; col0 = 256 * pn + 128 * (wc >> 1) + i0; col1 = col0 + 64; scale = pn >= 5 ? 0.08838834764831845f : 1.0f; }
        else if (pn == 2 && wc >= 2) { col0 = 640 + 32 * (wc - 2) + 8 * fq; col1 = col0 + 64; }
        else { rope = true; tab = ropeA; tabw = 32; i0 = 8 * fq; col0 = (pn < 2 ? 256 * pn : 512) + 64 * wc + i0; col1 = col0 + 32; scale = pn < 2 ? 0.18033688011112042f   : 1.0f; }
        float rsv[2][4];
        {
            f32x4 sq[2][4];
#pragma unroll
            for (int ai = 0; ai < 2; ++ai)
#pragma unroll
                for (int m = 0; m < 4; ++m) sq[ai][m] = *(const f32x4*)(ssq + (size_t)(rowb + ai * 128 + m * 16) * 16 + 4 * fq);
#pragma unroll
            for (int ai = 0; ai < 2; ++ai)
#pragma unroll
                for (int m = 0; m < 4; ++m) {
                    float s = (sq[ai][m][0] + sq[ai][m][1]) + (sq[ai][m][2] + sq[ai][m][3]);
                    s += __shfl_xor(s, 16); s += __shfl_xor(s, 32);
                    rsv[ai][m] = __builtin_amdgcn_rsqf(s * (1.0f / 1024.0f) + EPS) * scale;
                }
        }
#pragma unroll
        for (int am = 0; am < 4; ++am) {
            const int ai = am >> 1;
            f32x4 tb[2][4];
            if (rope) {
#pragma unroll
                for (int mm = 0; mm < 2; ++mm) { const int m = 2 * (am & 1) + mm; const f32x4* tp = tab + ((size_t)((rowb + ai * 128 + m * 16) & seqmask) * tabw + i0) / 2;
#pragma unroll
                    for (int q = 0; q < 4; ++q) tb[mm][q] = tp[q]; }
            }
#pragma unroll
            for (int mm = 0; mm < 2; ++mm) {
                const int m = 2 * (am & 1) + mm;
                const int row = rowb + ai * 128 + m * 16;
                const float rs = rsv[ai][m];
                f32x4 a0 = acc[ai][0][m][0] * rs, a1 = acc[ai][0][m][1] * rs, b0 = acc[ai][1][m][0] * rs, b1 = acc[ai][1][m][1] * rs;
                if (rope) {
                    const f32x4 t0 = tb[mm][0], t1 = tb[mm][1], t2 = tb[mm][2], t3 = tb[mm][3];
                    f32x4 x, y;
                    x[0] = a0[0] * t0[0] - b0[0] * t0[1]; y[0] = b0[0] * t0[0] + a0[0] * t0[1];
                    x[1] = a0[1] * t0[2] - b0[1] * t0[3]; y[1] = b0[1] * t0[2] + a0[1] * t0[3];
                    x[2] = a0[2] * t1[0] - b0[2] * t1[1]; y[2] = b0[2] * t1[0] + a0[2] * t1[1];
                    x[3] = a0[3] * t1[2] - b0[3] * t1[3]; y[3] = b0[3] * t1[2] + a0[3] * t1[3];
                    a0 = x; b0 = y;
                    x[0] = a1[0] * t2[0] - b1[0] * t2[1]; y[0] = b1[0] * t2[0] + a1[0] * t2[1];
                    x[1] = a1[1] * t2[2] - b1[1] * t2[3]; y[1] = b1[1] * t2[2] + a1[1] * t2[3];
                    x[2] = a1[2] * t3[0] - b1[2] * t3[1]; y[2] = b1[2] * t3[0] + a1[2] * t3[1];
                    x[3] = a1[3] * t3[2] - b1[3] * t3[3]; y[3] = b1[3] * t3[2] + a1[3] * t3[3];
                    a1 = x; b1 = y;
                }
                if (sigm) {
#pragma unroll
                    for (int j = 0; j < 4; ++j) { a0[j] = __builtin_amdgcn_rcpf(1.0f + __builtin_amdgcn_exp2f(a0[j])); a1[j] = __builtin_amdgcn_rcpf(1.0f + __builtin_amdgcn_exp2f(a1[j])); b0[j] = __builtin_amdgcn_rcpf(1.0f + __builtin_amdgcn_exp2f(b0[j])); b1[j] = __builtin_amdgcn_rcpf(1.0f + __builtin_amdgcn_exp2f(b1[j])); }
                }
                u32x4 w0, w1;
                w0.x = cvt_pk_bf16(a0[0], a0[1]); w0.y = cvt_pk_bf16(a0[2], a0[3]); w0.z = cvt_pk_bf16(a1[0], a1[1]); w0.w = cvt_pk_bf16(a1[2], a1[3]);
                w1.x = cvt_pk_bf16(b0[0], b0[1]); w1.y = cvt_pk_bf16(b0[2], b0[3]); w1.z = cvt_pk_bf16(b1[0], b1[1]); w1.w = cvt_pk_bf16(b1[2], b1[3]);
                bf16_t* rp = dst + (size_t)row * ld;
                *(u32x4*)(rp + col0) = w0; *(u32x4*)(rp + col1) = w1;
            }
        }
    }
};

struct EpiMerge {
    static constexpr bool PERM = true;
    static __device__ __forceinline__ bool keep_acc(const Unit& u) { return u.asel == 0; }
    bf16_t* merged; const bf16_t* gates;
    __device__ __forceinline__ void operator()(f32x4 (&acc)[2][2][4][2], const Unit& u, int wr, int wc, int fr, int fq) const {
        const int type = u.asel, rowb = u.pm * 256 + wr * 64 + fr, colb = 256 * (u.pn & 3) + 32 * wc + 8 * fq;
#pragma unroll
        for (int ai = 0; ai < 2; ++ai) {
            u32x4 g0q[4][2], g1q[4][2];
#pragma unroll
            for (int m = 0; m < 4; ++m)
#pragma unroll
                for (int bj = 0; bj < 2; ++bj) {
                    const bf16_t* gp = gates + (size_t)(rowb + ai * 128 + m * 16) * GW + colb + 128 * bj;
                    g1q[m][bj] = *(const u32x4*)(gp + 1024);
                    if (!type) g0q[m][bj] = *(const u32x4*)gp;
                }
#pragma unroll
            for (int m = 0; m < 4; ++m)
#pragma unroll
                for (int bj = 0; bj < 2; ++bj) {
                    const u32x4 g1 = g1q[m][bj];
                    f32x4 s0 = (f32x4){bf_lo(g1.x), bf_hi(g1.x), bf_lo(g1.y), bf_hi(g1.y)}, s1 = (f32x4){bf_lo(g1.z), bf_hi(g1.z), bf_lo(g1.w), bf_hi(g1.w)};
                    if (!type) {
                        const u32x4 g0 = g0q[m][bj];
#pragma unroll
                        for (int j = 0; j < 4; ++j) { s0[j] = __builtin_amdgcn_rcpf(fmaxf(s0[j], 1e-30f)); s1[j] = __builtin_amdgcn_rcpf(fmaxf(s1[j], 1e-30f)); }
                        s0 = s0 * (f32x4){bf_lo(g0.x), bf_hi(g0.x), bf_lo(g0.y), bf_hi(g0.y)}; s1 = s1 * (f32x4){bf_lo(g0.z), bf_hi(g0.z), bf_lo(g0.w), bf_hi(g0.w)};
                        acc[ai][bj][m][0] = acc[ai][bj][m][0] * s0; acc[ai][bj][m][1] = acc[ai][bj][m][1] * s1;
                    } else {
                        const f32x4 v0 = acc[ai][bj][m][0] * s0, v1 = acc[ai][bj][m][1] * s1;
                        u32x4 w; w.x = cvt_pk_bf16(v0[0], v0[1]); w.y = cvt_pk_bf16(v0[2], v0[3]); w.z = cvt_pk_bf16(v1[0], v1[1]); w.w = cvt_pk_bf16(v1[2], v1[3]);
                        *(u32x4*)(merged + (size_t)(rowb + ai * 128 + m * 16) * DM + colb + 128 * bj) = w;
                    }
                }
        }
    }
};

template <bool SRC_F32> struct EpiResid {
    static constexpr bool PERM = true;
    static __device__ __forceinline__ bool keep_acc(const Unit&) { return false; }
    const float* xsrc; bf16_t* xb; float* ssq;
    __device__ __forceinline__ void operator()(f32x4 (&acc)[2][2][4][2], const Unit& u, int wr, int wc, int fr, int fq) const {
        const int rowb = u.pm * 256 + wr * 64 + fr, colb = u.pn * 256 + wc * 32 + 8 * fq;
#pragma unroll
        for (int ai = 0; ai < 2; ++ai) {
            f32x4 x0[4][2], x1[4][2];
#pragma unroll
            for (int m = 0; m < 4; ++m)
#pragma unroll
                for (int bj = 0; bj < 2; ++bj) {
                    const size_t o = (size_t)(rowb + ai * 128 + m * 16) * DM + colb + bj * 128;
                    if (SRC_F32) { x0[m][bj] = *(const f32x4*)(xsrc + o); x1[m][bj] = *(const f32x4*)(xsrc + o + 4); }
                    else { const u32x4 q = *(const u32x4*)(xb + o); x0[m][bj] = (f32x4){bf_lo(q.x), bf_hi(q.x), bf_lo(q.y), bf_hi(q.y)}; x1[m][bj] = (f32x4){bf_lo(q.z), bf_hi(q.z), bf_lo(q.w), bf_hi(q.w)}; }
                }
#pragma unroll
            for (int m = 0; m < 4; ++m) {
                const int row = rowb + ai * 128 + m * 16; float part = 0.f;
#pragma unroll
                for (int bj = 0; bj < 2; ++bj) {
                    const f32x4 a = x0[m][bj] + acc[ai][bj][m][0], b = x1[m][bj] + acc[ai][bj][m][1];
                    u32x4 w; w.x = cvt_pk_bf16(a[0], a[1]); w.y = cvt_pk_bf16(a[2], a[3]); w.z = cvt_pk_bf16(b[0], b[1]); w.w = cvt_pk_bf16(b[2], b[3]);
                    *(u32x4*)(xb + (size_t)row * DM + colb + bj * 128) = w;
                    part += ((a[0] * a[0] + a[1] * a[1]) + (a[2] * a[2] + a[3] * a[3])) + ((b[0] * b[0] + b[1] * b[1]) + (b[2] * b[2] + b[3] * b[3]));
                }
                part += __shfl_xor(part, 16); part += __shfl_xor(part, 32);
                if (fq == 0) ssq[(size_t)row * 16 + u.pn * 4 + wc] = part;
            }
        }
    }
};

__device__ __forceinline__ float dpp_prev(float v, float old) { return __builtin_bit_cast(float, __builtin_amdgcn_update_dpp(__builtin_bit_cast(int, old), __builtin_bit_cast(int, v), 0x111, 0xf, 0xf, false)); }
__device__ __forceinline__ float dpp_next(float v, float old) { return __builtin_bit_cast(float, __builtin_amdgcn_update_dpp(__builtin_bit_cast(int, old), __builtin_bit_cast(int, v), 0x101, 0xf, 0xf, false)); }
__device__ __forceinline__ float dpp_ror1(float v) { return __builtin_bit_cast(float, __builtin_amdgcn_mov_dpp(__builtin_bit_cast(int, v), 0x121, 0xf, 0xf, true)); }
__device__ __forceinline__ float dpp_ror15(float v) { return __builtin_bit_cast(float, __builtin_amdgcn_mov_dpp(__builtin_bit_cast(int, v), 0x12f, 0xf, 0xf, true)); }
struct EpiFfnConv {
    static constexpr bool PERM = true;
    static __device__ __forceinline__ bool keep_acc(const Unit&) { return false; }
    bf16_t* act; const float* ssq; const float* cw; const float* cb; LAS float* X; int S;
    __device__ __forceinline__ void operator()(f32x4 (&acc)[2][2][4][2], const Unit& u, int wr, int wc, int fr, int fq) const {
        asm volatile("" : "+v"(fr), "+v"(fq));
        const int row0 = 254 * u.pm - 1, f0 = 128 * u.pn + 32 * wc + 8 * fq, ib = 64 * wr + fr;
        const bool edge = row0 < 0 || ((row0 + 1) & ~(S - 1)) != ((row0 + 256) & ~(S - 1)) || (row0 & ~(S - 1)) != ((row0 + 255) & ~(S - 1));
        f32x4 w0[2], w1[2], w2[2], bb[2];
#pragma unroll
        for (int n = 0; n < 2; ++n) { w0[n] = *(const f32x4*)(cw + f0 + 4 * n); w1[n] = *(const f32x4*)(cw + FF + f0 + 4 * n); w2[n] = *(const f32x4*)(cw + 2 * FF + f0 + 4 * n); bb[n] = *(const f32x4*)(cb + f0 + 4 * n); }
        f32x4 av[2][4][2], uv[2][4][2];
        {
            f32x4 sq[2][4];
#pragma unroll
            for (int ai = 0; ai < 2; ++ai)
#pragma unroll
                for (int m = 0; m < 4; ++m) { int row = row0 + 128 * ai + 16 * m + ib; row = row < 0 ? 0 : (row > SLAB - 1 ? SLAB - 1 : row); sq[ai][m] = *(const f32x4*)(ssq + (size_t)row * 16 + 4 * fq); }
#pragma unroll
            for (int ai = 0; ai < 2; ++ai)
#pragma unroll
                for (int m = 0; m < 4; ++m) {
                    float s = (sq[ai][m][0] + sq[ai][m][1]) + (sq[ai][m][2] + sq[ai][m][3]);
                    s += __shfl_xor(s, 16); s += __shfl_xor(s, 32);
                    const float rs = __builtin_amdgcn_rsqf(s * (1.0f / 1024.0f) + EPS);
#pragma unroll
                    for (int n = 0; n < 2; ++n) { av[ai][m][n] = acc[ai][0][m][n] * rs; uv[ai][m][n] = acc[ai][1][m][n] * rs; }
                }
        }
        const int xo = 32 * wc + 8 * fq;
#pragma unroll
        for (int ai = 0; ai < 2; ++ai) {
            if (fr == 0) { *(LAS f32x4*)(X + ((2 * ai + wr) * 2 + 0) * 128 + xo) = av[ai][0][0]; *(LAS f32x4*)(X + ((2 * ai + wr) * 2 + 0) * 128 + xo + 4) = av[ai][0][1]; }
            if (fr == 15) { *(LAS f32x4*)(X + ((2 * ai + wr) * 2 + 1) * 128 + xo) = av[ai][3][0]; *(LAS f32x4*)(X + ((2 * ai + wr) * 2 + 1) * 128 + xo + 4) = av[ai][3][1]; }
        }
        asm volatile("s_waitcnt lgkmcnt(0)" ::: "memory"); __builtin_amdgcn_s_barrier(); asm volatile("" ::: "memory"); __builtin_amdgcn_s_barrier(); asm volatile("" ::: "memory");
#pragma unroll
        for (int ai = 0; ai < 2; ++ai) {
            const int g4 = 2 * ai + wr, gp = g4 > 0 ? g4 - 1 : 0, gn = g4 < 3 ? g4 + 1 : 3;
            f32x4 xp[2], xn[2];
#pragma unroll
            for (int n = 0; n < 2; ++n) { xp[n] = *(const LAS f32x4*)(X + (gp * 2 + 1) * 128 + xo + 4 * n); xn[n] = *(const LAS f32x4*)(X + (gn * 2 + 0) * 128 + xo + 4 * n); }
#pragma unroll
            for (int m = 0; m < 4; ++m) {
                const int i = 128 * ai + 16 * m + ib, row = row0 + i, pos = row & (S - 1);
                u32x4 o;
#pragma unroll
                for (int n = 0; n < 2; ++n) {
                    f32x4 pv, nv;
#pragma unroll
                    for (int e = 0; e < 4; ++e) {
                        const float a = av[ai][m][n][e];
                        pv[e] = dpp_prev(a, m > 0 ? dpp_ror1(av[ai][m > 0 ? m - 1 : 0][n][e]) : xp[n][e]);
                        nv[e] = dpp_next(a, m < 3 ? dpp_ror15(av[ai][m < 3 ? m + 1 : 3][n][e]) : xn[n][e]);
                    }
                    if (edge) {
#pragma unroll
                        for (int e = 0; e < 4; ++e) { pv[e] = pos == 0 ? 0.f : pv[e]; nv[e] = pos == S - 1 ? 0.f : nv[e]; }
                    }
                    const f32x4 v = bb[n] + w0[n] * pv + w1[n] * av[ai][m][n] + w2[n] * nv;
                    const f32x2 g01 = gelu_pk((f32x2){v[0], v[1]}), g23 = gelu_pk((f32x2){v[2], v[3]});
                    const f32x4 uu = uv[ai][m][n];
                    if (n == 0) { o.x = cvt_pk_bf16(g01.x * uu[0], g01.y * uu[1]); o.y = cvt_pk_bf16(g23.x * uu[2], g23.y * uu[3]); }
                    else { o.z = cvt_pk_bf16(g01.x * uu[0], g01.y * uu[1]); o.w = cvt_pk_bf16(g23.x * uu[2], g23.y * uu[3]); }
                }
                if (i >= 1 && i <= 254 && row < SLAB) *(u32x4*)(act + (size_t)row * FF + f0) = o;
            }
        }
    }
};

#define TR8(base, O0, O1, O2, O3, O4, O5, O6, O7, r) \
    asm volatile("ds_read_b64_tr_b16 %0, %8 offset:" #O0 "\n\tds_read_b64_tr_b16 %1, %8 offset:" #O1 "\n\tds_read_b64_tr_b16 %2, %8 offset:" #O2 "\n\tds_read_b64_tr_b16 %3, %8 offset:" #O3 "\n\t" \
                 "ds_read_b64_tr_b16 %4, %8 offset:" #O4 "\n\tds_read_b64_tr_b16 %5, %8 offset:" #O5 "\n\tds_read_b64_tr_b16 %6, %8 offset:" #O6 "\n\tds_read_b64_tr_b16 %7, %8 offset:" #O7 "\n\t" \
                 "s_waitcnt lgkmcnt(0)" \
                 : "=&v"(r[0]), "=&v"(r[1]), "=&v"(r[2]), "=&v"(r[3]), "=&v"(r[4]), "=&v"(r[5]), "=&v"(r[6]), "=&v"(r[7]) : "v"(base) : "memory")
__device__ __forceinline__ bf16x8 cat4(s16x4 lo, s16x4 hi) { return __builtin_shufflevector(lo, hi, 0, 1, 2, 3, 4, 5, 6, 7); }
__device__ __forceinline__ bf16x8 pack8(f32x4 a, f32x4 b) { u32x4 w; w.x = cvt_pk_bf16(a[0], a[1]); w.y = cvt_pk_bf16(a[2], a[3]); w.z = cvt_pk_bf16(b[0], b[1]); w.w = cvt_pk_bf16(b[2], b[3]); return __builtin_bit_cast(bf16x8, w); }
__device__ __forceinline__ unsigned lds_addr(LAS unsigned char* p) { return (unsigned)(size_t)p; }

constexpr int AP = 144;
struct AttnKV { u32x4 k[6], v[6]; };
__device__ __forceinline__ void attn_load(AttnKV& r, const bf16_t* qkvg, int item, int nbs) {
    const int tid = opaque_tid(), bi = item >> 1, hk = item & 1, bis = bi & (nbs - 1), row0 = bi * 128;
    const bool has_prev = bis > 0, has_next = bis < nbs - 1;
#pragma unroll
    for (int i = 0; i < 6; ++i) {
        const int c = tid + 512 * i, rr = c >> 3, ch = c & 7, jb = rr >> 7;
        const bool valid = (jb == 1) || (jb == 0 ? has_prev : has_next);
        r.k[i] = (u32x4){0u, 0u, 0u, 0u}; r.v[i] = (u32x4){0u, 0u, 0u, 0u};
        if (valid) { const bf16_t* p = qkvg + (size_t)(row0 - 128 + rr) * QW + 512 + hk * 64 + ch * 8; r.k[i] = *(const u32x4*)p; r.v[i] = *(const u32x4*)(p + 128); }
    }
}
__device__ __forceinline__ void attn_item(LAS unsigned char* lds, bf16_t* qkvg, const float* sink8, int item, int nbs, const AttnKV& kvr) {
    const int tid = opaque_tid(), lane = tid & 63, w = tid >> 6, g = lane >> 4, li = lane & 15, qq = li >> 2, pp = li & 3;
    const int bi = item >> 1, hk = item & 1, bis = bi & (nbs - 1), row0 = bi * 128;
    const bool has_prev = bis > 0, has_next = bis < nbs - 1;
    LAS unsigned char* Kl = lds; LAS unsigned char* Vl = lds + 384 * AP;
#pragma unroll
    for (int i = 0; i < 6; ++i) {
        const int c = tid + 512 * i, r = c >> 3, ch = c & 7;
        *(LAS u32x4*)(Kl + r * AP + ch * 16) = kvr.k[i]; *(LAS u32x4*)(Vl + r * AP + ch * 16) = kvr.v[i];
    }
    __syncthreads();
    const int head = hk * 4 + (w >> 1);
    const float sink = sink8[head] * 1.4426950408889634f;
    const unsigned vaddr0 = lds_addr(Vl) + (unsigned)((4 * g + qq) * AP + pp * 8);
#pragma unroll 1
    for (int pass = 0; pass < 4; ++pass) {
        const int qr0 = (w & 1) * 64 + pass * 16, r = qr0 + li;
        bf16_t* qp = qkvg + (size_t)(row0 + r) * QW + head * 64;
        const bf16x8 qf0 = *(const bf16x8*)(qp + 8 * g), qf1 = *(const bf16x8*)(qp + 32 + 8 * g);
        const int qt = qr0 >> 4;
        f32x4 st[24];
#pragma unroll
        for (int kt = 0; kt < 24; ++kt) {
            f32x4 a = (f32x4){0.f, 0.f, 0.f, 0.f};
            if (!((kt < 8 && kt < qt) || (kt >= 16 && kt - 16 > qt))) {
                LAS unsigned char* kp = Kl + (16 * kt + li) * AP + g * 16;
                a = mfma16(*(const LAS bf16x8*)kp, qf0, a); a = mfma16(*(const LAS bf16x8*)(kp + 64), qf1, a);
            }
            st[kt] = a;
        }
        float mx = sink;
#pragma unroll
        for (int kt = 0; kt < 24; ++kt)
#pragma unroll
            for (int j = 0; j < 4; ++j) {
                const int c = (16 * kt + 4 * g + j) & 127;
                const bool ok = (kt >= 8 && kt < 16) ? true : (kt < 8 ? (has_prev && c >= r) : (has_next && c <= r));
                st[kt][j] = ok ? st[kt][j] : -1e30f;
            }
#pragma unroll
        for (int kt = 0; kt < 24; ++kt) { mx = fmaxf(fmaxf(mx, st[kt][0]), st[kt][1]); mx = fmaxf(fmaxf(mx, st[kt][2]), st[kt][3]); }
        mx = fmaxf(mx, __shfl_xor(mx, 16)); mx = fmaxf(mx, __shfl_xor(mx, 32));
        float sum = 0.f;
#pragma unroll
        for (int kt = 0; kt < 24; ++kt)
#pragma unroll
            for (int j = 0; j < 4; ++j) { const float p = __builtin_amdgcn_exp2f(st[kt][j] - mx); st[kt][j] = p; sum += p; }
        sum += __shfl_xor(sum, 16); sum += __shfl_xor(sum, 32);
        const float inv = 1.0f / (sum + __builtin_amdgcn_exp2f(sink - mx));
        f32x4 o[4];
#pragma unroll
        for (int dt = 0; dt < 4; ++dt) o[dt] = (f32x4){0.f, 0.f, 0.f, 0.f};
#pragma unroll
        for (int ks = 0; ks < 12; ++ks) {
            if ((ks < 4 && 2 * ks + 1 < qt) || (ks >= 8 && 2 * ks - 16 > qt)) continue;
            s16x4 tr[8];
            const unsigned addr = vaddr0 + (unsigned)(ks * 32 * AP);
            TR8(addr, 0, 32, 64, 96, 2304, 2336, 2368, 2400, tr);
            const bf16x8 pf = pack8(st[2 * ks], st[2 * ks + 1]);
#pragma unroll
            for (int dt = 0; dt < 4; ++dt) o[dt] = mfma16(cat4(tr[dt], tr[4 + dt]), pf, o[dt]);
        }
#pragma unroll
        for (int dt = 0; dt < 4; ++dt) {
            u32x2 wv; wv.x = cvt_pk_bf16(o[dt][0] * inv, o[dt][1] * inv); wv.y = cvt_pk_bf16(o[dt][2] * inv, o[dt][3] * inv);
            *(u32x2*)(qp + 16 * dt + 4 * g) = wv;
        }
    }
    __syncthreads();
}

constexpr int RP = 272;
constexpr int RT = 128 * RP;
struct StateKV { u32x4 k[4], v[4]; };
__device__ __forceinline__ void ret_state_load(StateKV& r, const bf16_t* qkvg, int item) {
    const int tid = opaque_tid(), cgi = item >> 2, h = item & 3, row0 = cgi * 128;
#pragma unroll
    for (int i = 0; i < 4; ++i) {
        const int c = tid + 512 * i, rr = c >> 4, ch = c & 15;
        const bf16_t* p = qkvg + (size_t)(row0 + rr) * QW + 1280 + h * 128 + ch * 8;
        r.k[i] = *(const u32x4*)p; r.v[i] = *(const u32x4*)(p + 512);
    }
}
__device__ __forceinline__ void ret_state_item(LAS unsigned char* lds, const bf16_t* qkvg, bf16_t* SF, bf16_t* SB, const float* lgf, const float* lgb, int item, const StateKV& kvr) {
    const int tid = opaque_tid(), lane = tid & 63, w = tid >> 6, g = lane >> 4, li = lane & 15, qq = li >> 2, pp = li & 3;
    const int cgi = item >> 2, h = item & 3;
    const float lf2 = lgf[h] * 1.4426950408889634f, lb2 = lgb[h] * 1.4426950408889634f;
    LAS unsigned char* Kf = lds; LAS unsigned char* Kb = lds + RT; LAS unsigned char* Vl = lds + 2 * RT;
#pragma unroll
    for (int i = 0; i < 4; ++i) {
        const int c = tid + 512 * i, r = c >> 4, ch = c & 15;
        const u32x4 kr = kvr.k[i], vr = kvr.v[i];
        const float zf = __builtin_amdgcn_exp2f(lf2 * (float)(127 - r)), zb = __builtin_amdgcn_exp2f(lb2 * (float)r);
        u32x4 kf, kb;
        kf.x = cvt_pk_bf16(bf_lo(kr.x) * zf, bf_hi(kr.x) * zf); kf.y = cvt_pk_bf16(bf_lo(kr.y) * zf, bf_hi(kr.y) * zf); kf.z = cvt_pk_bf16(bf_lo(kr.z) * zf, bf_hi(kr.z) * zf); kf.w = cvt_pk_bf16(bf_lo(kr.w) * zf, bf_hi(kr.w) * zf);
        kb.x = cvt_pk_bf16(bf_lo(kr.x) * zb, bf_hi(kr.x) * zb); kb.y = cvt_pk_bf16(bf_lo(kr.y) * zb, bf_hi(kr.y) * zb); kb.z = cvt_pk_bf16(bf_lo(kr.z) * zb, bf_hi(kr.z) * zb); kb.w = cvt_pk_bf16(bf_lo(kr.w) * zb, bf_hi(kr.w) * zb);
        *(LAS u32x4*)(Kf + r * RP + ch * 16) = kf; *(LAS u32x4*)(Kb + r * RP + ch * 16) = kb; *(LAS u32x4*)(Vl + r * RP + ch * 16) = vr;
    }
    __syncthreads();
    const unsigned lane_off = (unsigned)((8 * g + qq) * RP + pp * 8);
    s16x4 tv[8];
    { const unsigned a = lds_addr(Vl) + lane_off + (unsigned)(w * 32); TR8(a, 0, 8704, 17408, 26112, 1088, 9792, 18496, 27200, tv); }
    bf16x8 vf[4];
#pragma unroll
    for (int ks = 0; ks < 4; ++ks) vf[ks] = cat4(tv[ks], tv[4 + ks]);
#pragma unroll
    for (int dir = 0; dir < 2; ++dir) {
        bf16_t* ST = (dir ? SB : SF) + ((size_t)(cgi * 4 + h) * 128 + 16 * w + li) * 128 + 4 * g;
        const unsigned kbase = lds_addr(dir ? Kb : Kf) + lane_off;
#pragma unroll
        for (int dt = 0; dt < 8; ++dt) {
            s16x4 ta[8];
            const unsigned a = kbase + (unsigned)(dt * 32);
            TR8(a, 0, 8704, 17408, 26112, 1088, 9792, 18496, 27200, ta);
            f32x4 acc = (f32x4){0.f, 0.f, 0.f, 0.f};
#pragma unroll
            for (int ks = 0; ks < 4; ++ks) acc = mfma16(cat4(ta[ks], ta[4 + ks]), vf[ks], acc);
            u32x2 wv; wv.x = cvt_pk_bf16(acc[0], acc[1]); wv.y = cvt_pk_bf16(acc[2], acc[3]);
            *(u32x2*)(ST + 16 * dt) = wv;
        }
    }
    __syncthreads();
}

__device__ __forceinline__ void ret_scan(bf16_t* SF, bf16_t* SB, const float* lgf, const float* lgb, int nseq, int ncs, int gtid, int gthreads) {
    const int total = nseq * 4 * 2 * 4096;
    for (int idx = gtid; idx < total; idx += gthreads) {
        const int e4 = idx & 4095, dir = (idx >> 12) & 1, h = (idx >> 13) & 3, seq = idx >> 15;
        const float dec = __expf((dir ? lgb[h] : lgf[h]) * 128.0f);
        bf16_t* base = (dir ? SB : SF) + (size_t)h * 16384 + (size_t)e4 * 4;
        const int c0 = seq * ncs;
        float r0 = 0.f, r1 = 0.f, r2 = 0.f, r3 = 0.f;
        for (int cb = 0; cb < ncs; cb += 8) {
            u32x2 kv[8];
#pragma unroll
            for (int j = 0; j < 8; ++j) { const int c = dir ? (ncs - 1 - (cb + j)) : (cb + j); kv[j] = *(const u32x2*)(base + (size_t)(c0 + c) * 65536); }
#pragma unroll
            for (int j = 0; j < 8; ++j) { const int c = dir ? (ncs - 1 - (cb + j)) : (cb + j);
                u32x2 o; o.x = cvt_pk_bf16(r0, r1); o.y = cvt_pk_bf16(r2, r3);
                *(u32x2*)(base + (size_t)(c0 + c) * 65536) = o;
                r0 = r0 * dec + bf_lo(kv[j].x); r1 = r1 * dec + bf_hi(kv[j].x); r2 = r2 * dec + bf_lo(kv[j].y); r3 = r3 * dec + bf_hi(kv[j].y); }
        }
    }
}

__device__ __forceinline__ void ret_out_item(LAS unsigned char* lds, bf16_t* qkvg, const bf16_t* SF, const bf16_t* SB, const float* lgf, const float* lgb, const float* normg, int item) {
    const int tid = opaque_tid(), lane = tid & 63, w = tid >> 6, g = lane >> 4, li = lane & 15, qq = li >> 2, pp = li & 3;
    const int cgi = item >> 2, h = item & 3, row0 = cgi * 128;
    const float lf2 = lgf[h] * 1.4426950408889634f, lb2 = lgb[h] * 1.4426950408889634f;
    LAS unsigned char* Kl = lds; LAS unsigned char* Vl = lds + RT; LAS unsigned char* Rf = lds + 2 * RT; LAS unsigned char* Rb = lds + 3 * RT;
#pragma unroll
    for (int i = 0; i < 4; ++i) {
        const int c = tid + 512 * i, r = c >> 4, ch = c & 15;
        const bf16_t* p = qkvg + (size_t)(row0 + r) * QW + 1280 + h * 128 + ch * 8;
        const size_t so = ((size_t)(cgi * 4 + h) * 128 + r) * 128 + ch * 8;
        const u32x4 kr = *(const u32x4*)p, vr = *(const u32x4*)(p + 512), rf = *(const u32x4*)(SF + so), rb = *(const u32x4*)(SB + so);
        *(LAS u32x4*)(Kl + r * RP + ch * 16) = kr; *(LAS u32x4*)(Vl + r * RP + ch * 16) = vr; *(LAS u32x4*)(Rf + r * RP + ch * 16) = rf; *(LAS u32x4*)(Rb + r * RP + ch * 16) = rb;
    }
    const int n = 16 * w + li;
    bf16_t* qp = qkvg + (size_t)(row0 + n) * QW + 768 + h * 128;
    bf16x8 qf[4];
#pragma unroll
    for (int s = 0; s < 4; ++s) qf[s] = *(const bf16x8*)(qp + 32 * s + 8 * g);
    __syncthreads();
    f32x4 st[8];
#pragma unroll
    for (int kt = 0; kt < 8; ++kt) {
        LAS unsigned char* kp = Kl + (16 * kt + li) * RP + g * 16;
        f32x4 a = (f32x4){0.f, 0.f, 0.f, 0.f};
#pragma unroll
        for (int s = 0; s < 4; ++s) a = mfma16(*(const LAS bf16x8*)(kp + 64 * s), qf[s], a);
#pragma unroll
        for (int j = 0; j < 4; ++j) { const int dl = n - (16 * kt + 4 * g + j); a[j] *= __builtin_amdgcn_exp2f(dl >= 0 ? lf2 * (float)dl : -lb2 * (float)dl); }
        st[kt] = a;
    }
    f32x4 o[8], of[8], ob[8];
#pragma unroll
    for (int et = 0; et < 8; ++et) { o[et] = (f32x4){0.f, 0.f, 0.f, 0.f}; of[et] = o[et]; ob[et] = o[et]; }
    const unsigned vaddr0 = lds_addr(Vl) + (unsigned)((4 * g + qq) * RP + pp * 8);
#pragma unroll
    for (int ks = 0; ks < 4; ++ks) {
        s16x4 t0[8], t1[8];
        const unsigned addr = vaddr0 + (unsigned)(ks * 32 * RP);
        TR8(addr, 0, 32, 64, 96, 4352, 4384, 4416, 4448, t0);
        TR8(addr, 128, 160, 192, 224, 4480, 4512, 4544, 4576, t1);
        const bf16x8 pf = pack8(st[2 * ks], st[2 * ks + 1]);
#pragma unroll
        for (int et = 0; et < 4; ++et) { o[et] = mfma16(cat4(t0[et], t0[4 + et]), pf, o[et]); o[4 + et] = mfma16(cat4(t1[et], t1[4 + et]), pf, o[4 + et]); }
    }
#pragma unroll
    for (int et = 0; et < 8; ++et) {
        LAS unsigned char* fp = Rf + (16 * et + li) * RP + g * 16; LAS unsigned char* bp = Rb + (16 * et + li) * RP + g * 16;
#pragma unroll
        for (int s = 0; s < 4; ++s) { of[et] = mfma16(*(const LAS bf16x8*)(fp + 64 * s), qf[s], of[et]); ob[et] = mfma16(*(const LAS bf16x8*)(bp + 64 * s), qf[s], ob[et]); }
    }
    const float xf = __builtin_amdgcn_exp2f(lf2 * (float)(n + 1)), xb = __builtin_amdgcn_exp2f(lb2 * (float)(128 - n));
    float ss = 0.f;
#pragma unroll
    for (int et = 0; et < 8; ++et)
#pragma unroll
        for (int j = 0; j < 4; ++j) { const float v = o[et][j] + xf * of[et][j] + xb * ob[et][j]; o[et][j] = v; ss += v * v; }
    ss += __shfl_xor(ss, 16); ss += __shfl_xor(ss, 32);
    const float rinv = __builtin_amdgcn_rsqf(ss * (1.0f / 128.0f) + EPS);
#pragma unroll
    for (int et = 0; et < 8; ++et) {
        const int e0 = 16 * et + 4 * g;
        const u32x2 gr = *(const u32x2*)(qp + 1536 + e0);
        const f32x4 ng = *(const f32x4*)(normg + h * 128 + e0);
        const float g0 = bf_lo(gr.x), g1 = bf_hi(gr.x), g2 = bf_lo(gr.y), g3 = bf_hi(gr.y);
        const float v0 = o[et][0] * rinv * ng[0] * g0 * sigmoid_f(g0), v1 = o[et][1] * rinv * ng[1] * g1 * sigmoid_f(g1);
        const float v2 = o[et][2] * rinv * ng[2] * g2 * sigmoid_f(g2), v3 = o[et][3] * rinv * ng[3] * g3 * sigmoid_f(g3);
        u32x2 wv; wv.x = cvt_pk_bf16(v0, v1); wv.y = cvt_pk_bf16(v2, v3);
        *(u32x2*)(qp + e0) = wv;
    }
    __syncthreads();
}
struct Params {
    const float* x_prompt; const float* x_sample; const float* norm_mix_g; const float* w_in; const float* attn_sink; const float* lgf; const float* lgb; const float* ret_norm_g;
    const float* w_battn; const float* w_bret; const float* w_out; const float* norm_ffn_g; const float* w_ffn_in; const float* conv_w; const float* conv_b; const float* w_ffn_out; const float* final_g;
    float* out; unsigned char* ws;
};

__device__ __forceinline__ void transpose_item(const float* W, int K, int N, const float* gain, bf16_t* WT, int k0, int nsrc0, int prow0, LAS float* scr, int lane) {
    const int kr = lane >> 3, c4 = (lane & 7) * 4;
    f32x4 v[8];
#pragma unroll
    for (int i = 0; i < 8; ++i) v[i] = *(const f32x4*)(W + (size_t)(k0 + kr + 8 * i) * N + nsrc0 + c4);
#pragma unroll
    for (int i = 0; i < 8; ++i) { const float gsc = gain ? gain[k0 + kr + 8 * i] : 1.0f; LAS float* d = scr + (kr + 8 * i) * 33 + c4;
        d[0] = v[i][0] * gsc; d[1] = v[i][1] * gsc; d[2] = v[i][2] * gsc; d[3] = v[i][3] * gsc; }
    asm volatile("s_waitcnt lgkmcnt(0)" ::: "memory");
    const int c = lane & 7;
#pragma unroll
    for (int j = 0; j < 4; ++j) { const int n = (lane >> 3) + 8 * j; const LAS float* s = scr + (8 * c) * 33 + n;
        u32x4 o; o.x = cvt_pk_bf16(s[0 * 33], s[1 * 33]); o.y = cvt_pk_bf16(s[2 * 33], s[3 * 33]); o.z = cvt_pk_bf16(s[4 * 33], s[5 * 33]); o.w = cvt_pk_bf16(s[6 * 33], s[7 * 33]);
        *(u32x4*)(WT + (size_t)(prow0 + n) * K + k0 + 8 * c) = o; }
    asm volatile("s_waitcnt lgkmcnt(0)" ::: "memory");
}
__device__ __forceinline__ int win_src_col(int p0) {
    const int pn = p0 >> 8, p = p0 & 255, bj = p >> 7, j = p & 127;
    if (pn < 2) return 256 * pn + 64 * (j >> 5) + 32 * bj + (j & 31);
    if (pn == 2) return j < 64 ? 512 + 64 * (j >> 5) + 32 * bj + (j & 31) : 640 + 64 * bj + (j - 64);
    if (pn < 7) return 256 * pn + 128 * (j >> 6) + 64 * bj + (j & 63);
    return p0;
}
#if defined(__HIP_DEVICE_COMPILE__)
typedef const __attribute__((address_space(4))) Params* kparams_t;
__device__ __forceinline__ Params fresh_params() { kparams_t p = (kparams_t)__builtin_amdgcn_kernarg_segment_ptr(); asm volatile("" : "+s"(p)); return *p; }
#else
__device__ __forceinline__ Params fresh_params() { return Params{}; }
#endif
constexpr int I_IN = 16 * (INW / 32), I_BR = 8 * 32, I_OUT = 16 * 32, I_F1 = 16 * (FF2 / 32), I_F2 = (FF / 64) * 32, I_L = I_IN + 2 * I_BR + I_OUT + I_F1 + I_F2;
__device__ __forceinline__ void convert_weights(const Params& P, LAS unsigned char* lds, int it_lo, int it_hi, int wrank, int wcount) {
    const int tid = opaque_tid(), lane = tid & 63, w = tid >> 6;
    LAS float* scr = (LAS float*)(lds + w * 8448);
    for (int it = it_lo + wrank; it < it_hi; it += wcount) {
        const int l = it / I_L; int r = it % I_L;
        if (r < I_IN) { const int kb = r / (INW / 32), nb = r % (INW / 32);
            transpose_item(P.w_in + (size_t)l * DM * INW, DM, INW, P.norm_mix_g + l * DM, (bf16_t*)(P.ws + WS_WIN + l * SZ_WIN), 64 * kb, win_src_col(32 * nb), 32 * nb, scr, lane); continue; } r -= I_IN;
        if (r < I_BR) { const int kb = r / 32, nb = r % 32;
            transpose_item(P.w_battn + (size_t)l * 512 * DM, 512, DM, nullptr, (bf16_t*)(P.ws + WS_WBR + l * SZ_WBR), 64 * kb, 32 * nb, 32 * nb, scr, lane); continue; } r -= I_BR;
        if (r < I_BR) { const int kb = r / 32, nb = r % 32;
            transpose_item(P.w_bret + (size_t)l * 512 * DM, 512, DM, nullptr, (bf16_t*)(P.ws + WS_WBR + l * SZ_WBR), 64 * kb, 32 * nb, 1024 + 32 * nb, scr, lane); continue; } r -= I_BR;
        if (r < I_OUT) { const int kb = r / 32, nb = r % 32;
            transpose_item(P.w_out + (size_t)l * DM * DM, DM, DM, nullptr, (bf16_t*)(P.ws + WS_WOUT + l * SZ_WOUT), 64 * kb, 32 * nb, 32 * nb, scr, lane); continue; } r -= I_OUT;
        if (r < I_F1) { const int kb = r / (FF2 / 32), nb = r % (FF2 / 32);
            const int p0 = 32 * nb;
            transpose_item(P.w_ffn_in + (size_t)l * DM * FF2, DM, FF2, P.norm_ffn_g + l * DM, (bf16_t*)(P.ws + WS_WF1 + l * SZ_WF1), 64 * kb, ((p0 >> 7) & 1) * FF + 128 * (p0 >> 8) + (p0 & 127), p0, scr, lane); continue; } r -= I_F1;
        { const int kb = r / 32, nb = r % 32;
            transpose_item(P.w_ffn_out + (size_t)l * FF * DM, FF, DM, nullptr, (bf16_t*)(P.ws + WS_WF2 + l * SZ_WF2), 64 * kb, 32 * nb, 32 * nb, scr, lane); }
    }
}
template <int NR> __device__ __forceinline__ void convert_rows(const Params& P, int row_lo, int row_hi, int wrank, int wcount) {
    const int lane = opaque_tid() & 63;
    for (int row = row_lo + NR * wrank; row < row_hi; row += NR * wcount) {
        f32x4 v[NR][4];
#pragma unroll
        for (int r = 0; r < NR; ++r) { const int rr = row + r; const float* xr = rr < SLAB ? P.x_prompt + (size_t)rr * DM : P.x_sample + (size_t)(rr - SLAB) * DM;
#pragma unroll
            for (int j = 0; j < 4; ++j) v[r][j] = *(const f32x4*)(xr + 256 * j + 4 * lane); }
#pragma unroll
        for (int r = 0; r < NR; ++r) {
            bf16_t* xb = (bf16_t*)(P.ws + WS_XB) + (size_t)(row + r) * DM;
            float s = 0.f;
#pragma unroll
            for (int j = 0; j < 4; ++j) { const f32x4 x = v[r][j]; s += (x[0] * x[0] + x[1] * x[1]) + (x[2] * x[2] + x[3] * x[3]);
                u32x2 o; o.x = cvt_pk_bf16(x[0], x[1]); o.y = cvt_pk_bf16(x[2], x[3]); *(u32x2*)(xb + 256 * j + 4 * lane) = o; }
#pragma unroll
            for (int o = 1; o < 64; o <<= 1) s += __shfl_xor(s, o);
            if (lane < 16) ((float*)(P.ws + WS_SSQ))[(size_t)(row + r) * 16 + lane] = lane == 0 ? s : 0.f;
        }
    }
}
__device__ __forceinline__ void prologue_phase(const Params& P, LAS unsigned char* lds) {
    const int tid = opaque_tid(), w = tid >> 6;
    const int gw = blockIdx.x * 8 + w, ngw = gridDim.x * 8;
    convert_weights(P, lds, 0, I_IN, gw, ngw);
    const int gt = blockIdx.x * 512 + tid, ngt = gridDim.x * 512;
    for (int idx = gt; idx < 8192 * 96; idx += ngt) {
        const int pos = idx / 96, t = idx % 96, half = t < 32 ? 32 : 64, i = t < 32 ? t : t - 32;
        const double freq = exp2(-(double)i / (double)half * 13.287712379549449);
        const double turns = (double)pos * freq * 0.15915494309189535;
        const float fr = (float)(turns - rint(turns));
        f32x2 cs; cs.x = cospif(2.0f * fr); cs.y = sinpif(2.0f * fr);
        f32x2* dst = t < 32 ? (f32x2*)(P.ws + WS_ROPEA) + (size_t)pos * 32 + i : (f32x2*)(P.ws + WS_ROPER) + (size_t)pos * 64 + i;
        *dst = cs;
    }
    convert_rows<4>(P, 0, SLAB, gw, ngw);
}
__device__ __forceinline__ bool idle_rank(int nwg, int G, int c, int& rank, int& count) {
    const int rem = nwg % G;
    if (rem == 0) { rank = c; count = G; return true; }
    rank = c - rem; count = G - rem; return c >= rem;
}

__device__ __forceinline__ void final_norm_rows(const Params& P, int row_lo, int row_hi, int gw, int ngw) {
    const int lane = opaque_tid() & 63;
    const float* ssq = (const float*)(P.ws + WS_SSQ); const bf16_t* xball = (const bf16_t*)(P.ws + WS_XB);
    f32x4 gv[4];
#pragma unroll
    for (int j = 0; j < 4; ++j) gv[j] = *(const f32x4*)(P.final_g + 256 * j + 4 * lane);
    for (int row = row_lo + 2 * gw; row < row_hi; row += 2 * ngw) {
        u32x2 q[2][4]; float sv[2];
#pragma unroll
        for (int r = 0; r < 2; ++r) {
#pragma unroll
            for (int j = 0; j < 4; ++j) q[r][j] = *(const u32x2*)(xball + (size_t)(row + r) * DM + 256 * j + 4 * lane);
            sv[r] = lane < 16 ? ssq[(size_t)(row + r) * 16 + lane] : 0.f;
        }
#pragma unroll
        for (int r = 0; r < 2; ++r) {
            float s = sv[r];
#pragma unroll
            for (int o = 1; o < 16; o <<= 1) s += __shfl_xor(s, o);
            s = __shfl(s, 0);
            const float rinv = __builtin_amdgcn_rsqf(s * (1.0f / 1024.0f) + EPS);
            float* xr = P.out + (size_t)(row + r) * DM;
#pragma unroll
            for (int j = 0; j < 4; ++j) { f32x4 v = (f32x4){bf_lo(q[r][j].x), bf_hi(q[r][j].x), bf_lo(q[r][j].y), bf_hi(q[r][j].y)}; v = v * rinv * gv[j]; *(f32x4*)(xr + 256 * j + 4 * lane) = v; }
        }
    }
}

#define XB_TMO      128
#define XB_XCNT(j)  (256  + 64 * (j))
#define XB_XSUB(j)  (1280 + 64 * (j))
#define XB_XGEN(j)  (2304 + 64 * (j))
#define XB_TOP      3328
#define XB_TOPGEN   3392
#define XCD_BAR_WORDS 3456
#define XB_SPIN_CAP (1u << 18)

__device__ __forceinline__ unsigned xb_ld(unsigned* p)              { return __hip_atomic_load(p, __ATOMIC_RELAXED, __HIP_MEMORY_SCOPE_AGENT); }
__device__ __forceinline__ unsigned xb_add(unsigned* p, unsigned v) { return __hip_atomic_fetch_add(p, v, __ATOMIC_RELAXED, __HIP_MEMORY_SCOPE_AGENT); }
__device__ __forceinline__ unsigned xb_xcc_id() { return (unsigned)__builtin_amdgcn_s_getreg((3 << 11) | 20) & 0xFu; }
#define XB_SPIN(cond, bar) do { unsigned _sp = 0; while (cond) { __builtin_amdgcn_s_sleep(1); \
    if ((++_sp & 255u) == 0u) { if (xb_ld(&(bar)[XB_TMO])) break; if (_sp > XB_SPIN_CAP) { atomicAdd(&(bar)[XB_TMO], 1u); break; } } } } while (0)

struct XcdBarrier {
    unsigned* bar; unsigned x;
    volatile LAS unsigned* st;
};

__device__ __forceinline__ XcdBarrier xcd_barrier_post(unsigned* bar, volatile LAS unsigned* st) {
    XcdBarrier b; b.bar = bar; b.x = xb_xcc_id(); b.st = st;
    if (threadIdx.x == 0) (void)xb_add(&bar[XB_XCNT(b.x)], 1u);
    return b;
}
__device__ __forceinline__ void xcd_barrier_complete(unsigned* bar, unsigned x, unsigned& nloc, unsigned& nx) {
    const unsigned G = gridDim.x * gridDim.y * gridDim.z;
    unsigned sum, cnt, mine, sp = 0u;
    for (;;) {
        sum = 0u; cnt = 0u; mine = 0u;
#pragma unroll
        for (unsigned j = 0; j < 16; ++j) { const unsigned c = xb_ld(&bar[XB_XCNT(j)]); sum += c; cnt += (c > 0u) ? 1u : 0u; mine = (j == x) ? c : mine; }
        if (sum == G) break;
        __builtin_amdgcn_s_sleep(1);
        if ((++sp & 255u) == 0u) { if (xb_ld(&bar[XB_TMO])) break; if (sp > XB_SPIN_CAP) { atomicAdd(&bar[XB_TMO], 1u); break; } }
    }
    nloc = mine > 0u ? mine : 1u; nx = cnt > 0u ? cnt : 1u;
}

__device__ __forceinline__ void xcd_barrier(const XcdBarrier& b) {
    asm volatile("s_waitcnt vmcnt(0)" ::: "memory");
    __syncthreads();
    if (threadIdx.x == 0) {
        unsigned* bar = b.bar;
        __builtin_amdgcn_s_waitcnt(0);
        unsigned nloc = b.st[0], nx = b.st[1];
        if (nloc == 0u) { xcd_barrier_complete(bar, b.x, nloc, nx); b.st[0] = nloc; b.st[1] = nx; }
        const unsigned old = xb_add(&bar[XB_XSUB(b.x)], 1u);
        const unsigned gen = old / nloc;
        if (old + 1u == (gen + 1u) * nloc) {
            __builtin_amdgcn_fence(__ATOMIC_RELEASE, "agent");
            asm volatile("s_waitcnt vmcnt(0)" ::: "memory");
            const unsigned og = xb_add(&bar[XB_TOP], 1u);
            const unsigned tg = og / nx;
            if (og + 1u == (tg + 1u) * nx) xb_add(&bar[XB_TOPGEN], 1u);
            else XB_SPIN(xb_ld(&bar[XB_TOPGEN]) == tg, bar);
            __builtin_amdgcn_fence(__ATOMIC_ACQUIRE, "agent");
            xb_add(&bar[XB_XGEN(b.x)], 1u);
            asm volatile("s_waitcnt vmcnt(0)" ::: "memory");
        } else {
            XB_SPIN(xb_ld(&bar[XB_XGEN(b.x)]) == gen, bar);
            __builtin_amdgcn_fence(__ATOMIC_ACQUIRE, "agent");
            asm volatile("s_waitcnt vmcnt(0)" ::: "memory");
        }
    }
    __syncthreads();
}


#define GSYNC() xcd_barrier(gbar)
__global__ __launch_bounds__(512, 2) void fwd_megakernel(Params P) {
    extern __shared__ __attribute__((aligned(16))) unsigned char shm[];
    LAS unsigned char* lds = (LAS unsigned char*)shm;
    cg::grid_group grid = cg::this_grid();
    const int G = gridDim.x, c = blockIdx.x;
    volatile LAS unsigned* xst = (volatile LAS unsigned*)(lds + LDS_BYTES - 16);
    if (threadIdx.x == 0) { xst[0] = 0u; xst[1] = 0u; }
    __syncthreads();
    const XcdBarrier gbar = xcd_barrier_post((unsigned*)(P.ws + WS_BAR), xst);
    prologue_phase(fresh_params(), lds);
    grid.sync();
#pragma unroll 1
    for (int l = 0; l < DEPTH; ++l) {
#pragma unroll 1
        for (int s = 0; s < NSLAB; ++s) {
#define SLAB_PTRS const Params Q = fresh_params(); const size_t r0 = (size_t)s * SLAB; unsigned char* SLB = Q.ws + WS_SLAB; \
            bf16_t* xb = (bf16_t*)(Q.ws + WS_XB) + r0 * DM; float* ssq = (float*)(Q.ws + WS_SSQ) + r0 * 16; float* xo = Q.out + r0 * DM; \
            bf16_t* qkvg = (bf16_t*)(SLB + SL_QKVG); bf16_t* gates = (bf16_t*)(SLB + SL_GATES); bf16_t* SF = (bf16_t*)(SLB + SL_SF); bf16_t* SB = (bf16_t*)(SLB + SL_SB); \
            bf16_t* merged = (bf16_t*)(SLB + SL_MERGED); bf16_t* act = (bf16_t*)(SLB + SL_ACT); \
            (void)xb; (void)ssq; (void)xo; (void)qkvg; (void)gates; (void)SF; (void)SB; (void)merged; (void)act
            {
                SLAB_PTRS;
                pg8::Gemm g{xb, xb, (const bf16_t*)(Q.ws + WS_WIN + l * SZ_WIN), DM, DM, DM};
                pg8::StaticOrder S; S.init(SLAB, INW, G, c);
                EpiProj E{qkvg, gates, ssq, (const f32x4*)(Q.ws + WS_ROPEA), (const f32x4*)(Q.ws + WS_ROPER), s == 0 ? 2047 : 8191};
                pg8::gemm_phase(lds, g, S, E);
                if (l == 0 && s < 2) { int rk, cnt;
                    if (idle_rank(S.nwg, G, c, rk, cnt)) { const Params PF = fresh_params(); const int wr_ = rk * 8 + (opaque_tid() >> 6), wc_ = cnt * 8;
                        if (s == 0) convert_weights(PF, lds, I_IN, I_L - I_F2, wr_, wc_); else convert_rows<2>(PF, 2 * SLAB, T_ALL, wr_, wc_); } }
            }
            GSYNC();
            {
                SLAB_PTRS;
                const int nbs = s == 0 ? 16 : 64;
                for (int a0 = c; a0 < 256; a0 += G) {
                    const int a = G == 256 ? (((a0 & 7) * 16 + (a0 >> 4)) * 2 + ((a0 >> 3) & 1)) : a0;
                    StateKV k0, k1; AttnKV k2;
                    ret_state_load(k0, qkvg, a);
                    ret_state_load(k1, qkvg, a + 256);
                    ret_state_item(lds, qkvg, SF, SB, Q.lgf + l * 4, Q.lgb + l * 4, a, k0);
                    attn_load(k2, qkvg, a, nbs);
                    ret_state_item(lds, qkvg, SF, SB, Q.lgf + l * 4, Q.lgb + l * 4, a + 256, k1);
                    attn_item(lds, qkvg, Q.attn_sink + l * 8, a, nbs, k2);
                }
            }
            GSYNC();
            {
                SLAB_PTRS;
                ret_scan(SF, SB, Q.lgf + l * 4, Q.lgb + l * 4, s == 0 ? 8 : 2, s == 0 ? 16 : 64, c * 512 + opaque_tid(), G * 512);
            }
            GSYNC();
            {
                SLAB_PTRS;
                for (int it = c; it < 512; it += G) ret_out_item(lds, qkvg, SF, SB, Q.lgf + l * 4, Q.lgb + l * 4, Q.ret_norm_g + l * 512, it);
            }
            GSYNC();
            {
                SLAB_PTRS;
                pg8::Gemm g{qkvg, qkvg + 768, (const bf16_t*)(Q.ws + WS_WBR + l * SZ_WBR), 512, QW, 512};
                pg8::MergeOrder S; S.init(SLAB, G, c);
                EpiMerge E{merged, gates};
                pg8::gemm_phase(lds, g, S, E);
            }
            GSYNC();
            {
                SLAB_PTRS;
                pg8::Gemm g{merged, merged, (const bf16_t*)(Q.ws + WS_WOUT + l * SZ_WOUT), DM, DM, DM};
                pg8::StaticOrder S; S.init(SLAB, DM, G, c);
                if (l == 0) { EpiResid<true> E{s == 0 ? Q.x_prompt : Q.x_sample + (size_t)(s - 1) * SLAB * DM, xb, ssq}; pg8::gemm_phase(lds, g, S, E); }
                else { EpiResid<false> E{nullptr, xb, ssq}; pg8::gemm_phase(lds, g, S, E); }
            }
            GSYNC();
            {
                SLAB_PTRS;
                pg8::Gemm g{xb, xb, (const bf16_t*)(Q.ws + WS_WF1 + l * SZ_WF1), DM, DM, DM};
                pg8::FfnOrder S4; S4.init(65, FF2, G, c);
                EpiFfnConv E{act, ssq, Q.conv_w + (size_t)l * 3 * FF, Q.conv_b + (size_t)l * FF, (LAS float*)(lds + 131072), s == 0 ? 2048 : 8192};
                pg8::gemm_phase(lds, g, S4, E);
                if (l == 0 && s < 2) { int rk, cnt;
                    if (idle_rank(S4.so.nwg, G, c, rk, cnt)) { const Params PF = fresh_params(); const int wr_ = rk * 8 + (opaque_tid() >> 6), wc_ = cnt * 8;
                        if (s == 0) { convert_weights(PF, lds, I_L - I_F2, I_L + I_IN, wr_, wc_); convert_rows<2>(PF, SLAB, 2 * SLAB, wr_, wc_); }
                        else convert_weights(PF, lds, I_L + I_IN, 2 * I_L, wr_, wc_); } }
                if (l == DEPTH - 1 && s >= 1) { int rk, cnt;
                    if (idle_rank(S4.so.nwg, G, c, rk, cnt)) final_norm_rows(fresh_params(), (s - 1) * SLAB, s * SLAB, rk * 8 + (opaque_tid() >> 6), cnt * 8); }
            }
            GSYNC();
            {
                SLAB_PTRS;
                pg8::Gemm g{act, act, (const bf16_t*)(Q.ws + WS_WF2 + l * SZ_WF2), FF, FF, FF};
                pg8::StaticOrder S; S.init(SLAB, DM, G, c);
                EpiResid<false> E{nullptr, xb, ssq};
                pg8::gemm_phase(lds, g, S, E);
            }
            GSYNC();
#undef SLAB_PTRS
        }
    }
    final_norm_rows(fresh_params(), 2 * SLAB, T_ALL, c * 8 + (opaque_tid() >> 6), G * 8);
}

extern "C" void kernel_launch(void* const* d_in, const int* in_sizes, int n_in, void* d_out, int out_size, void* d_ws, size_t ws_size, hipStream_t stream) {
    static int grid_blocks = 0;
    if (!grid_blocks) {
        int dev = 0, cus = 0, per_cu = 0;
        hipGetDevice(&dev);
        hipDeviceGetAttribute(&cus, hipDeviceAttributeMultiprocessorCount, dev);
        hipFuncSetAttribute((const void*)fwd_megakernel, hipFuncAttributeMaxDynamicSharedMemorySize, LDS_BYTES);
        hipOccupancyMaxActiveBlocksPerMultiprocessor(&per_cu, (const void*)fwd_megakernel, 512, LDS_BYTES);
        if (per_cu < 1) per_cu = 1;
        grid_blocks = cus * per_cu;
        if (ws_size < WS_END) fprintf(stderr, "workspace too small: %zu < %zu\n", ws_size, (size_t)WS_END);
    }
    if (hipMemsetAsync((unsigned char*)d_ws + WS_BAR, 0, 16384, stream) != hipSuccess) fprintf(stderr, "memset of the barrier words failed\n");
    Params p{};
    p.x_prompt = (const float*)d_in[0]; p.x_sample = (const float*)d_in[1]; p.norm_mix_g = (const float*)d_in[2]; p.w_in = (const float*)d_in[3]; p.attn_sink = (const float*)d_in[4];
    p.lgf = (const float*)d_in[5]; p.lgb = (const float*)d_in[6]; p.ret_norm_g = (const float*)d_in[7]; p.w_battn = (const float*)d_in[8]; p.w_bret = (const float*)d_in[9]; p.w_out = (const float*)d_in[10];
    p.norm_ffn_g = (const float*)d_in[11]; p.w_ffn_in = (const float*)d_in[12]; p.conv_w = (const float*)d_in[13]; p.conv_b = (const float*)d_in[14]; p.w_ffn_out = (const float*)d_in[15]; p.final_g = (const float*)d_in[16];
    p.out = (float*)d_out; p.ws = (unsigned char*)d_ws;
    void* args[] = {&p};
    hipError_t e = hipLaunchCooperativeKernel((const void*)fwd_megakernel, dim3(grid_blocks), dim3(512), args, LDS_BYTES, stream);
    if (e != hipSuccess) fprintf(stderr, "cooperative launch failed: %s (grid %d)\n", hipGetErrorString(e), grid_blocks);
}
```

```cpp
#include <hip/hip_runtime.h>
#include <hip/hip_cooperative_groups.h>
#include <cstdio>
namespace cg = cooperative_groups;

#define LAS __attribute__((address_space(3)))
typedef unsigned short bf16_t;
typedef short bf16x8 __attribute__((ext_vector_type(8)));
typedef short s16x4 __attribute__((ext_vector_type(4)));
typedef float f32x4 __attribute__((ext_vector_type(4)));
typedef float f32x2 __attribute__((ext_vector_type(2)));
typedef unsigned u32x4 __attribute__((ext_vector_type(4)));
typedef unsigned u32x2 __attribute__((ext_vector_type(2)));

constexpr int T_ALL = 49152, SLAB = 16384, NSLAB = 3, DM = 1024, INW = 4864, QW = 2816, GW = 2048, FF = 2816, FF2 = 5632, DEPTH = 2;
constexpr int LDS_BYTES = 147456;
constexpr float EPS = 1e-6f;
constexpr size_t SZ_WIN = (size_t)INW * DM * 2, SZ_WBR = (size_t)2048 * 512 * 2, SZ_WOUT = (size_t)DM * DM * 2, SZ_WF1 = (size_t)FF2 * DM * 2, SZ_WF2 = (size_t)DM * FF * 2;
constexpr size_t WS_WIN = 0;
constexpr size_t WS_WBR = WS_WIN + DEPTH * SZ_WIN;
constexpr size_t WS_WOUT = WS_WBR + DEPTH * SZ_WBR;
constexpr size_t WS_WF1 = WS_WOUT + DEPTH * SZ_WOUT;
constexpr size_t WS_WF2 = WS_WF1 + DEPTH * SZ_WF1;
constexpr size_t WS_ROPEA = WS_WF2 + DEPTH * SZ_WF2;
constexpr size_t WS_ROPER = WS_ROPEA + (size_t)8192 * 32 * 8;
constexpr size_t WS_SSQ = WS_ROPER + (size_t)8192 * 64 * 8;
constexpr size_t WS_XB = WS_SSQ + (size_t)T_ALL * 16 * 4;
constexpr size_t WS_SLAB = WS_XB + (size_t)T_ALL * DM * 2;
constexpr size_t SL_QKVG = 0;
constexpr size_t SL_GATES = SL_QKVG + (size_t)SLAB * QW * 2;
constexpr size_t SL_SF = SL_GATES + (size_t)SLAB * GW * 2;
constexpr size_t SL_SB = SL_SF + (size_t)128 * 4 * 16384 * 2;
constexpr size_t SL_MERGED = SL_SB + (size_t)128 * 4 * 16384 * 2;
constexpr size_t SL_ACT = 0;
constexpr size_t WS_BAR = WS_SLAB + SL_MERGED + (size_t)SLAB * DM * 2;
constexpr size_t WS_END = WS_BAR + 16384;

__device__ __forceinline__ int opaque_tid() { int t = threadIdx.x; asm volatile("" : "+v"(t)); return t; }
typedef __bf16 bf16x2_t __attribute__((ext_vector_type(2)));
__device__ __forceinline__ unsigned cvt_pk_bf16(float lo, float hi) { f32x2 v; v.x = lo; v.y = hi; return __builtin_bit_cast(unsigned, __builtin_convertvector(v, bf16x2_t)); }
__device__ __forceinline__ float bf_lo(unsigned u) { return __uint_as_float(u << 16); }
__device__ __forceinline__ float bf_hi(unsigned u) { return __uint_as_float(u & 0xffff0000u); }
__device__ __forceinline__ f32x4 mfma16(bf16x8 a, bf16x8 b, f32x4 c) { return __builtin_amdgcn_mfma_f32_16x16x32_bf16(a, b, c, 0, 0, 0); }

#define PG8_LAS LAS
namespace pg8 {
constexpr int BM = 256, BK = 64, HALF = 128, HTB = HALF * BK * 2  , STAGE_BYTES = 8 * HTB, NXCD = 8, WGM = 8;
__host__ __device__ __forceinline__ int lds_byte(int r, int c) { const int st = (r >> 4) * 2 + (c >> 5), rr = r & 15, cc = c & 31, ob = rr * 64 + cc * 2; return st * 1024 + (ob ^ (((ob >> 9) & 1) << 5)); }
__host__ __device__ __forceinline__ void stage_rc(int b, int& R, int& C) { const int st = b / 1024, sb = b % 1024, swz = sb ^ (((sb >> 9) & 1) << 5); R = (st >> 1) * 16 + swz / 64; C = (st & 1) * 32 + (swz % 64) / 2; }
__host__ __device__ __forceinline__ int perm32(int rho) { const int n = rho >> 4, i = rho & 15; return 8 * (i >> 2) + 4 * n + (i & 3); }

struct Unit { int pm, pn, asel, arow; };
struct Gemm { const bf16_t* A; const bf16_t* A2; const bf16_t* Bt; int K, lda, ldb; };

struct StaticOrder {
    int nM, nN, nwg, G, c;
    __device__ void init(int M, int N, int G_, int c_) { nM = M / BM; nN = N / BM; nwg = nM * nN; G = G_; c = c_; }
    __device__ bool next(int i, Unit& u) const {
        const long L = (long)i * G + c; if (L >= nwg) return false;
        int wgid = (int)L; { const int q = nwg / NXCD, r = nwg % NXCD, xcd = wgid % NXCD, off = wgid / NXCD; wgid = (xcd < r ? xcd * (q + 1) : r * (q + 1) + (xcd - r) * q) + off; }
        const int nig = WGM * nN, gid = wgid / nig, fm = gid * WGM, gsz = (nM - fm) < WGM ? (nM - fm) : WGM;
        u.pm = fm + ((wgid % nig) % gsz); u.pn = (wgid % nig) / gsz; u.asel = 0; u.arow = u.pm * BM; return true;
    }
};
struct MergeOrder {
    int ntile, G, c;
    __device__ void init(int M, int G_, int c_) { ntile = (M / BM) * 4; G = G_; c = c_; }
    __device__ bool next(int i, Unit& u) const {
        const long t = (long)(i >> 1) * G + c; if (t >= ntile) return false;
        u.pm = (int)(t >> 2); u.asel = i & 1; u.pn = (int)(t & 3) + 4 * u.asel; u.arow = u.pm * BM; return true;
    }
};

struct FfnOrder {
    StaticOrder so;
    __device__ void init(int nMt, int N, int G_, int c_) { so.init(nMt * BM, N, G_, c_); }
    __device__ bool next(int i, Unit& u) const {
        if (!so.next(i, u)) return false;
        u.arow = 254 * u.pm - 1; return true;
    }
};

template <class Epi, class Sched>
__device__ __forceinline__ void gemm_phase(PG8_LAS unsigned char* lds, const Gemm g, const Sched& S, const Epi& E) {
    const int tid = opaque_tid(), wid = __builtin_amdgcn_readfirstlane(tid >> 6), lane = tid & 63, wr = wid >> 2, wc = wid & 3, fr = lane & 15, fq = lane >> 4;
    const int K = g.K, nt = K / BK;
    unsigned voffA[2], voffB[2];
#pragma unroll
    for (int i = 0; i < 2; ++i) { int R, C; stage_rc(tid * 16 + i * 8192, R, C); const int Rb = Epi::PERM ? ((R & ~31) + perm32(R & 31)) : R;
        voffA[i] = (unsigned)(R * g.lda + C) * 2u; voffB[i] = (unsigned)(Rb * g.ldb + C) * 2u; }
    const size_t kstep = (size_t)(BK * 2);
    const size_t hstepA = (size_t)HALF * g.lda * 2, hstepB = (size_t)HALF * g.ldb * 2;
    const size_t tstepB = 2 * hstepB;
    const unsigned ldsw = (unsigned)wid * 1024u;
    const int aoff = lds_byte(wr * 64 + fr, fq * 8), boff = lds_byte(wc * 32 + fr, fq * 8);
#define PG8_SA(b, h) (((b) * 2 + (h)) * HTB)
#define PG8_SB(b, h) ((4 + (b) * 2 + (h)) * HTB)
#define PG8_STAGE(bufoff, gbase, voff) do { _Pragma("unroll") for (int _i = 0; _i < 2; ++_i) \
        __builtin_amdgcn_global_load_lds((const unsigned*)((const char*)(gbase) + (voff)[_i]), (PG8_LAS unsigned*)(lds + (bufoff) + ldsw + _i * 8192), 16, 0, 0); } while (0)
#define PG8_LDA(dst, b, h) do { _Pragma("unroll") for (int m = 0; m < 4; ++m) _Pragma("unroll") for (int k = 0; k < 2; ++k) dst[m][k] = *(const PG8_LAS bf16x8*)(lds + PG8_SA(b, h) + aoff + m * 2048 + k * 1024); } while (0)
#define PG8_LDB(dst, b, h) do { _Pragma("unroll") for (int n = 0; n < 2; ++n) _Pragma("unroll") for (int k = 0; k < 2; ++k) dst[n][k] = *(const PG8_LAS bf16x8*)(lds + PG8_SB(b, h) + boff + n * 2048 + k * 1024); } while (0)
#define PG8_MMA(ai, bj, At, Bt) do { __builtin_amdgcn_s_setprio(1); _Pragma("unroll") for (int m = 0; m < 4; ++m) _Pragma("unroll") for (int n = 0; n < 2; ++n) _Pragma("unroll") for (int k = 0; k < 2; ++k) \
        acc[ai][bj][m][n] = __builtin_amdgcn_mfma_f32_16x16x32_bf16(Bt[n][k], At[m][k], acc[ai][bj][m][n], 0, 0, 0); __builtin_amdgcn_s_setprio(0); } while (0)
#define PG8_WAIT_V(n) asm volatile("s_waitcnt vmcnt(" #n ")" ::: "memory")
#define PG8_WAIT_L(n) asm volatile("s_waitcnt lgkmcnt(" #n ")" ::: "memory")
#define PG8_BAR __builtin_amdgcn_s_barrier()
#define PG8_SCHED __builtin_amdgcn_sched_barrier(0)
    Unit cur, nxt; int ui = 0;
    if (!S.next(0, cur)) return;
    f32x4 acc[2][2][4][2];
#pragma unroll
    for (int a = 0; a < 2; ++a)
#pragma unroll
        for (int b = 0; b < 2; ++b)
#pragma unroll
            for (int m = 0; m < 4; ++m)
#pragma unroll
                for (int n = 0; n < 2; ++n) acc[a][b][m][n] = (f32x4){0.f, 0.f, 0.f, 0.f};
    bf16x8 At[4][2], B0[2][2], B1[2][2];
    const long rstepA = (long)g.lda * 2;
    const char* cA = (const char*)(cur.asel ? g.A2 : g.A) + (long)cur.arow * rstepA; const char* cB = (const char*)g.Bt + (size_t)cur.pn * tstepB;
    PG8_STAGE(PG8_SB(0, 0), cB, voffB); PG8_STAGE(PG8_SA(0, 0), cA, voffA); PG8_STAGE(PG8_SB(0, 1), cB + hstepB, voffB); PG8_STAGE(PG8_SA(0, 1), cA + hstepA, voffA);
    if (wr == 1) PG8_BAR;
    PG8_WAIT_V(4); PG8_BAR;
    PG8_STAGE(PG8_SB(1, 0), cB + kstep, voffB); PG8_STAGE(PG8_SA(1, 0), cA + kstep, voffA); PG8_STAGE(PG8_SB(1, 1), cB + hstepB + kstep, voffB);
    PG8_WAIT_V(6); PG8_BAR;
    for (;;) {
        const bool has_next = S.next(ui + 1, nxt);
        const char* nA = has_next ? (const char*)(nxt.asel ? g.A2 : g.A) + (long)nxt.arow * rstepA : cA; const char* nB = has_next ? (const char*)g.Bt + (size_t)nxt.pn * tstepB : cB;
        for (int t = 0; t < nt; t += 2) {
            const bool last = (t == nt - 2);
            const char* a1 = cA + (size_t)(t + 1) * kstep;
            const char* a2 = last ? nA : cA + (size_t)(t + 2) * kstep; const char* b2 = last ? nB : cB + (size_t)(t + 2) * kstep;
            const char* a3 = a2 + kstep; const char* b3 = b2 + kstep;
            PG8_LDB(B0, 0, 0); PG8_SCHED; PG8_LDA(At, 0, 0); PG8_STAGE(PG8_SA(1, 1), a1 + hstepA, voffA);
            PG8_WAIT_L(8); PG8_BAR; PG8_WAIT_L(0); PG8_MMA(0, 0, At, B0); PG8_BAR; PG8_SCHED;
            PG8_LDB(B1, 0, 1); PG8_STAGE(PG8_SB(0, 0), b2, voffB);
            PG8_BAR; PG8_WAIT_L(0); PG8_MMA(0, 1, At, B1); PG8_BAR;
            PG8_LDA(At, 0, 1); PG8_STAGE(PG8_SA(0, 0), a2, voffA);
            PG8_BAR; PG8_WAIT_L(0); PG8_MMA(1, 0, At, B0); PG8_BAR; PG8_SCHED;
            PG8_STAGE(PG8_SB(0, 1), b2 + hstepB, voffB);
            PG8_WAIT_V(6); PG8_BAR; PG8_MMA(1, 1, At, B1); PG8_BAR;
            PG8_LDB(B0, 1, 0); PG8_SCHED; PG8_LDA(At, 1, 0); PG8_STAGE(PG8_SA(0, 1), a2 + hstepA, voffA);
            PG8_WAIT_L(8); PG8_BAR; PG8_WAIT_L(0); PG8_MMA(0, 0, At, B0); PG8_BAR; PG8_SCHED;
            PG8_LDB(B1, 1, 1); PG8_STAGE(PG8_SB(1, 0), b3, voffB);
            PG8_BAR; PG8_WAIT_L(0); PG8_MMA(0, 1, At, B1); PG8_BAR;
            PG8_LDA(At, 1, 1); PG8_STAGE(PG8_SA(1, 0), a3, voffA);
            PG8_BAR; PG8_WAIT_L(0); PG8_MMA(1, 0, At, B0); PG8_BAR; PG8_SCHED;
            PG8_STAGE(PG8_SB(1, 1), b3 + hstepB, voffB);
            PG8_WAIT_V(6); PG8_BAR; PG8_MMA(1, 1, At, B1); PG8_BAR;
        }
        E(acc, cur, wr, wc, fr, fq);
        if (!has_next) break;
        if (!Epi::keep_acc(cur))
#pragma unroll
        for (int a = 0; a < 2; ++a)
#pragma unroll
            for (int b = 0; b < 2; ++b)
#pragma unroll
                for (int m = 0; m < 4; ++m)
#pragma unroll
                    for (int n = 0; n < 2; ++n) acc[a][b][m][n] = (f32x4){0.f, 0.f, 0.f, 0.f};
        cur = nxt; cA = nA; cB = nB; ++ui;
    }
    PG8_WAIT_V(0);
    if (wr == 0) PG8_BAR;
    PG8_BAR;
#undef PG8_SA
#undef PG8_SB
#undef PG8_STAGE
#undef PG8_LDA
#undef PG8_LDB
#undef PG8_MMA
#undef PG8_WAIT_V
#undef PG8_WAIT_L
#undef PG8_BAR
#undef PG8_SCHED
}
}

using pg8::Unit;
__device__ __forceinline__ float row_rinv(const float* ssq, int row, int fq) {
    const f32x4 p = *(const f32x4*)(ssq + (size_t)row * 16 + 4 * fq);
    float s = (p[0] + p[1]) + (p[2] + p[3]);
    s += __shfl_xor(s, 16); s += __shfl_xor(s, 32);
    return __builtin_amdgcn_rsqf(s * (1.0f / 1024.0f) + EPS);
}
__device__ __forceinline__ float sigmoid_f(float x) { return __builtin_amdgcn_rcpf(1.0f + __expf(-x)); }

__device__ __forceinline__ f32x2 gelu_pk(f32x2 v) {
    const f32x2 av = __builtin_elementwise_abs(v), d = av * 0.2316418882f + 1.0f;
    f32x2 t; t.x = __builtin_amdgcn_rcpf(d.x); t.y = __builtin_amdgcn_rcpf(d.y);
    f32x2 q = t * 0.5307027145f + (-0.7265760135f); q = q * t + 0.7107068705f; q = q * t + (-0.142248368f); q = q * t + 0.127414796f; q = q * t;
    const f32x2 s = (v * v) * (-0.72134752044f);
    f32x2 e; e.x = __builtin_amdgcn_exp2f(s.x); e.y = __builtin_amdgcn_exp2f(s.y);
    const f32x2 m = v * (q * e);
    f32x2 o; o.x = fmaxf(v.x, 0.f) - fabsf(m.x); o.y = fmaxf(v.y, 0.f) - fabsf(m.y); return o;
}

struct EpiProj {
    static constexpr bool PERM = true;
    static __device__ __forceinline__ bool keep_acc(const Unit&) { return false; }
    bf16_t* qkvg; bf16_t* gates; const float* ssq; const f32x4* ropeA; const f32x4* ropeR; int seqmask;
    __device__ __forceinline__ void operator()(f32x4 (&acc)[2][2][4][2], const Unit& u, int wr, int wc, int fr, int fq) const {
        const int pn = u.pn, rowb = u.pm * 256 + wr * 64 + fr;
        bf16_t* dst = qkvg; int ld = QW, col0, col1, tabw = 0, i0 = 0; bool rope = false, sigm = false; float scale = 1.0f; const f32x4* tab = ropeA;
        if (pn >= 11) { dst = gates; ld = GW; col0 = 256 * (pn - 11) + 32 * wc + 8 * fq; col1 = col0 + 128; sigm = true; scale = -1.4426950408889634f; }
        else if (pn >= 7) { col0 = 256 * pn + 32 * wc + 8 * fq; col1 = col0 + 128; }
        else if (pn >= 3) { rope = true; tab = ropeR; tabw = 64; i0 = 32 * (wc & 1) + 8 * fq; col0 = 256 * pn + 128 * (wc >> 1) + i0; col1 = col0 + 64; scale = pn >= 5 ? 0.08838834764831845f : 1.0f; }
        else if (pn == 2 && wc >= 2) { col0 = 640 + 32 * (wc - 2) + 8 * fq; col1 = col0 + 64; }
        else { rope = true; tab = ropeA; tabw = 32; i0 = 8 * fq; col0 = (pn < 2 ? 256 * pn : 512) + 64 * wc + i0; col1 = col0 + 32; scale = pn < 2 ? 0.18033688011112042f   : 1.0f; }
        float rsv[2][4];
        {
            f32x4 sq[2][4];
#pragma unroll
            for (int ai = 0; ai < 2; ++ai)
#pragma unroll
                for (int m = 0; m < 4; ++m) sq[ai][m] = *(const f32x4*)(ssq + (size_t)(rowb + ai * 128 + m * 16) * 16 + 4 * fq);
#pragma unroll
            for (int ai = 0; ai < 2; ++ai)
#pragma unroll
                for (int m = 0; m < 4; ++m) {
                    float s = (sq[ai][m][0] + sq[ai][m][1]) + (sq[ai][m][2] + sq[ai][m][3]);
                    s += __shfl_xor(s, 16); s += __shfl_xor(s, 32);
                    rsv[ai][m] = __builtin_amdgcn_rsqf(s * (1.0f / 1024.0f) + EPS) * scale;
                }
        }
#pragma unroll
        for (int am = 0; am < 4; ++am) {
            const int ai = am >> 1;
            f32x4 tb[2][4];
            if (rope) {
#pragma unroll
                for (int mm = 0; mm < 2; ++mm) { const int m = 2 * (am & 1) + mm; const f32x4* tp = tab + ((size_t)((rowb + ai * 128 + m * 16) & seqmask) * tabw + i0) / 2;
#pragma unroll
                    for (int q = 0; q < 4; ++q) tb[mm][q] = tp[q]; }
            }
#pragma unroll
            for (int mm = 0; mm < 2; ++mm) {
                const int m = 2 * (am & 1) + mm;
                const int row = rowb + ai * 128 + m * 16;
                const float rs = rsv[ai][m];
                f32x4 a0 = acc[ai][0][m][0] * rs, a1 = acc[ai][0][m][1] * rs, b0 = acc[ai][1][m][0] * rs, b1 = acc[ai][1][m][1] * rs;
                if (rope) {
                    const f32x4 t0 = tb[mm][0], t1 = tb[mm][1], t2 = tb[mm][2], t3 = tb[mm][3];
                    f32x4 x, y;
                    x[0] = a0[0] * t0[0] - b0[0] * t0[1]; y[0] = b0[0] * t0[0] + a0[0] * t0[1];
                    x[1] = a0[1] * t0[2] - b0[1] * t0[3]; y[1] = b0[1] * t0[2] + a0[1] * t0[3];
                    x[2] = a0[2] * t1[0] - b0[2] * t1[1]; y[2] = b0[2] * t1[0] + a0[2] * t1[1];
                    x[3] = a0[3] * t1[2] - b0[3] * t1[3]; y[3] = b0[3] * t1[2] + a0[3] * t1[3];
                    a0 = x; b0 = y;
                    x[0] = a1[0] * t2[0] - b1[0] * t2[1]; y[0] = b1[0] * t2[0] + a1[0] * t2[1];
                    x[1] = a1[1] * t2[2] - b1[1] * t2[3]; y[1] = b1[1] * t2[2] + a1[1] * t2[3];
                    x[2] = a1[2] * t3[0] - b1[2] * t3[1]; y[2] = b1[2] * t3[0] + a1[2] * t3[1];
                    x[3] = a1[3] * t3[2] - b1[3] * t3[3]; y[3] = b1[3] * t3[2] + a1[3] * t3[3];
                    a1 = x; b1 = y;
                }
                if (sigm) {
#pragma unroll
                    for (int j = 0; j < 4; ++j) { a0[j] = __builtin_amdgcn_rcpf(1.0f + __builtin_amdgcn_exp2f(a0[j])); a1[j] = __builtin_amdgcn_rcpf(1.0f + __builtin_amdgcn_exp2f(a1[j])); b0[j] = __builtin_amdgcn_rcpf(1.0f + __builtin_amdgcn_exp2f(b0[j])); b1[j] = __builtin_amdgcn_rcpf(1.0f + __builtin_amdgcn_exp2f(b1[j])); }
                }
                u32x4 w0, w1;
                w0.x = cvt_pk_bf16(a0[0], a0[1]); w0.y = cvt_pk_bf16(a0[2], a0[3]); w0.z = cvt_pk_bf16(a1[0], a1[1]); w0.w = cvt_pk_bf16(a1[2], a1[3]);
                w1.x = cvt_pk_bf16(b0[0], b0[1]); w1.y = cvt_pk_bf16(b0[2], b0[3]); w1.z = cvt_pk_bf16(b1[0], b1[1]); w1.w = cvt_pk_bf16(b1[2], b1[3]);
                bf16_t* rp = dst + (size_t)row * ld;
                *(u32x4*)(rp + col0) = w0; *(u32x4*)(rp + col1) = w1;
            }
        }
    }
};

struct EpiMerge {
    static constexpr bool PERM = true;
    static __device__ __forceinline__ bool keep_acc(const Unit& u) { return u.asel == 0; }
    bf16_t* merged; const bf16_t* gates;
    __device__ __forceinline__ void operator()(f32x4 (&acc)[2][2][4][2], const Unit& u, int wr, int wc, int fr, int fq) const {
        const int type = u.asel, rowb = u.pm * 256 + wr * 64 + fr, colb = 256 * (u.pn & 3) + 32 * wc + 8 * fq;
#pragma unroll
        for (int ai = 0; ai < 2; ++ai) {
            u32x4 g0q[4][2], g1q[4][2];
#pragma unroll
            for (int m = 0; m < 4; ++m)
#pragma unroll
                for (int bj = 0; bj < 2; ++bj) {
                    const bf16_t* gp = gates + (size_t)(rowb + ai * 128 + m * 16) * GW + colb + 128 * bj;
                    g1q[m][bj] = *(const u32x4*)(gp + 1024);
                    if (!type) g0q[m][bj] = *(const u32x4*)gp;
                }
#pragma unroll
            for (int m = 0; m < 4; ++m)
#pragma unroll
                for (int bj = 0; bj < 2; ++bj) {
                    const u32x4 g1 = g1q[m][bj];
                    f32x4 s0 = (f32x4){bf_lo(g1.x), bf_hi(g1.x), bf_lo(g1.y), bf_hi(g1.y)}, s1 = (f32x4){bf_lo(g1.z), bf_hi(g1.z), bf_lo(g1.w), bf_hi(g1.w)};
                    if (!type) {
                        const u32x4 g0 = g0q[m][bj];
#pragma unroll
                        for (int j = 0; j < 4; ++j) { s0[j] = __builtin_amdgcn_rcpf(fmaxf(s0[j], 1e-30f)); s1[j] = __builtin_amdgcn_rcpf(fmaxf(s1[j], 1e-30f)); }
                        s0 = s0 * (f32x4){bf_lo(g0.x), bf_hi(g0.x), bf_lo(g0.y), bf_hi(g0.y)}; s1 = s1 * (f32x4){bf_lo(g0.z), bf_hi(g0.z), bf_lo(g0.w), bf_hi(g0.w)};
                        acc[ai][bj][m][0] = acc[ai][bj][m][0] * s0; acc[ai][bj][m][1] = acc[ai][bj][m][1] * s1;
                    } else {
                        const f32x4 v0 = acc[ai][bj][m][0] * s0, v1 = acc[ai][bj][m][1] * s1;
                        u32x4 w; w.x = cvt_pk_bf16(v0[0], v0[1]); w.y = cvt_pk_bf16(v0[2], v0[3]); w.z = cvt_pk_bf16(v1[0], v1[1]); w.w = cvt_pk_bf16(v1[2], v1[3]);
                        *(u32x4*)(merged + (size_t)(rowb + ai * 128 + m * 16) * DM + colb + 128 * bj) = w;
                    }
                }
        }
    }
};

template <bool SRC_F32> struct EpiResid {
    static constexpr bool PERM = true;
    static __device__ __forceinline__ bool keep_acc(const Unit&) { return false; }
    const float* xsrc; bf16_t* xb; float* ssq;
    __device__ __forceinline__ void operator()(f32x4 (&acc)[2][2][4][2], const Unit& u, int wr, int wc, int fr, int fq) const {
        const int rowb = u.pm * 256 + wr * 64 + fr, colb = u.pn * 256 + wc * 32 + 8 * fq;
#pragma unroll
        for (int ai = 0; ai < 2; ++ai) {
            f32x4 x0[4][2], x1[4][2];
#pragma unroll
            for (int m = 0; m < 4; ++m)
#pragma unroll
                for (int bj = 0; bj < 2; ++bj) {
                    const size_t o = (size_t)(rowb + ai * 128 + m * 16) * DM + colb + bj * 128;
                    if (SRC_F32) { x0[m][bj] = *(const f32x4*)(xsrc + o); x1[m][bj] = *(const f32x4*)(xsrc + o + 4); }
                    else { const u32x4 q = *(const u32x4*)(xb + o); x0[m][bj] = (f32x4){bf_lo(q.x), bf_hi(q.x), bf_lo(q.y), bf_hi(q.y)}; x1[m][bj] = (f32x4){bf_lo(q.z), bf_hi(q.z), bf_lo(q.w), bf_hi(q.w)}; }
                }
#pragma unroll
            for (int m = 0; m < 4; ++m) {
                const int row = rowb + ai * 128 + m * 16; float part = 0.f;
#pragma unroll
                for (int bj = 0; bj < 2; ++bj) {
                    const f32x4 a = x0[m][bj] + acc[ai][bj][m][0], b = x1[m][bj] + acc[ai][bj][m][1];
                    u32x4 w; w.x = cvt_pk_bf16(a[0], a[1]); w.y = cvt_pk_bf16(a[2], a[3]); w.z = cvt_pk_bf16(b[0], b[1]); w.w = cvt_pk_bf16(b[2], b[3]);
                    *(u32x4*)(xb + (size_t)row * DM + colb + bj * 128) = w;
                    part += ((a[0] * a[0] + a[1] * a[1]) + (a[2] * a[2] + a[3] * a[3])) + ((b[0] * b[0] + b[1] * b[1]) + (b[2] * b[2] + b[3] * b[3]));
                }
                part += __shfl_xor(part, 16); part += __shfl_xor(part, 32);
                if (fq == 0) ssq[(size_t)row * 16 + u.pn * 4 + wc] = part;
            }
        }
    }
};

__device__ __forceinline__ float dpp_prev(float v, float old) { return __builtin_bit_cast(float, __builtin_amdgcn_update_dpp(__builtin_bit_cast(int, old), __builtin_bit_cast(int, v), 0x111, 0xf, 0xf, false)); }
__device__ __forceinline__ float dpp_next(float v, float old) { return __builtin_bit_cast(float, __builtin_amdgcn_update_dpp(__builtin_bit_cast(int, old), __builtin_bit_cast(int, v), 0x101, 0xf, 0xf, false)); }
__device__ __forceinline__ float dpp_ror1(float v) { return __builtin_bit_cast(float, __builtin_amdgcn_mov_dpp(__builtin_bit_cast(int, v), 0x121, 0xf, 0xf, true)); }
__device__ __forceinline__ float dpp_ror15(float v) { return __builtin_bit_cast(float, __builtin_amdgcn_mov_dpp(__builtin_bit_cast(int, v), 0x12f, 0xf, 0xf, true)); }
struct EpiFfnConv {
    static constexpr bool PERM = true;
    static __device__ __forceinline__ bool keep_acc(const Unit&) { return false; }
    bf16_t* act; const float* ssq; const float* cw; const float* cb; LAS float* X; int S;
    __device__ __forceinline__ void operator()(f32x4 (&acc)[2][2][4][2], const Unit& u, int wr, int wc, int fr, int fq) const {
        asm volatile("" : "+v"(fr), "+v"(fq));
        const int row0 = 254 * u.pm - 1, f0 = 128 * u.pn + 32 * wc + 8 * fq, ib = 64 * wr + fr;
        const bool edge = row0 < 0 || ((row0 + 1) & ~(S - 1)) != ((row0 + 256) & ~(S - 1)) || (row0 & ~(S - 1)) != ((row0 + 255) & ~(S - 1));
        f32x4 w0[2], w1[2], w2[2], bb[2];
#pragma unroll
        for (int n = 0; n < 2; ++n) { w0[n] = *(const f32x4*)(cw + f0 + 4 * n); w1[n] = *(const f32x4*)(cw + FF + f0 + 4 * n); w2[n] = *(const f32x4*)(cw + 2 * FF + f0 + 4 * n); bb[n] = *(const f32x4*)(cb + f0 + 4 * n); }
        f32x4 av[2][4][2], uv[2][4][2];
        {
            f32x4 sq[2][4];
#pragma unroll
            for (int ai = 0; ai < 2; ++ai)
#pragma unroll
                for (int m = 0; m < 4; ++m) { int row = row0 + 128 * ai + 16 * m + ib; row = row < 0 ? 0 : (row > SLAB - 1 ? SLAB - 1 : row); sq[ai][m] = *(const f32x4*)(ssq + (size_t)row * 16 + 4 * fq); }
#pragma unroll
            for (int ai = 0; ai < 2; ++ai)
#pragma unroll
                for (int m = 0; m < 4; ++m) {
                    float s = (sq[ai][m][0] + sq[ai][m][1]) + (sq[ai][m][2] + sq[ai][m][3]);
                    s += __shfl_xor(s, 16); s += __shfl_xor(s, 32);
                    const float rs = __builtin_amdgcn_rsqf(s * (1.0f / 1024.0f) + EPS);
#pragma unroll
                    for (int n = 0; n < 2; ++n) { av[ai][m][n] = acc[ai][0][m][n] * rs; uv[ai][m][n] = acc[ai][1][m][n] * rs; }
                }
        }
        const int xo = 32 * wc + 8 * fq;
#pragma unroll
        for (int ai = 0; ai < 2; ++ai) {
            if (fr == 0) { *(LAS f32x4*)(X + ((2 * ai + wr) * 2 + 0) * 128 + xo) = av[ai][0][0]; *(LAS f32x4*)(X + ((2 * ai + wr) * 2 + 0) * 128 + xo + 4) = av[ai][0][1]; }
            if (fr == 15) { *(LAS f32x4*)(X + ((2 * ai + wr) * 2 + 1) * 128 + xo) = av[ai][3][0]; *(LAS f32x4*)(X + ((2 * ai + wr) * 2 + 1) * 128 + xo + 4) = av[ai][3][1]; }
        }
        asm volatile("s_waitcnt lgkmcnt(0)" ::: "memory"); __builtin_amdgcn_s_barrier(); asm volatile("" ::: "memory"); __builtin_amdgcn_s_barrier(); asm volatile("" ::: "memory");
#pragma unroll
        for (int ai = 0; ai < 2; ++ai) {
            const int g4 = 2 * ai + wr, gp = g4 > 0 ? g4 - 1 : 0, gn = g4 < 3 ? g4 + 1 : 3;
            f32x4 xp[2], xn[2];
#pragma unroll
            for (int n = 0; n < 2; ++n) { xp[n] = *(const LAS f32x4*)(X + (gp * 2 + 1) * 128 + xo + 4 * n); xn[n] = *(const LAS f32x4*)(X + (gn * 2 + 0) * 128 + xo + 4 * n); }
#pragma unroll
            for (int m = 0; m < 4; ++m) {
                const int i = 128 * ai + 16 * m + ib, row = row0 + i, pos = row & (S - 1);
                u32x4 o;
#pragma unroll
                for (int n = 0; n < 2; ++n) {
                    f32x4 pv, nv;
#pragma unroll
                    for (int e = 0; e < 4; ++e) {
                        const float a = av[ai][m][n][e];
                        pv[e] = dpp_prev(a, m > 0 ? dpp_ror1(av[ai][m > 0 ? m - 1 : 0][n][e]) : xp[n][e]);
                        nv[e] = dpp_next(a, m < 3 ? dpp_ror15(av[ai][m < 3 ? m + 1 : 3][n][e]) : xn[n][e]);
                    }
                    if (edge) {
#pragma unroll
                        for (int e = 0; e < 4; ++e) { pv[e] = pos == 0 ? 0.f : pv[e]; nv[e] = pos == S - 1 ? 0.f : nv[e]; }
                    }
                    const f32x4 v = bb[n] + w0[n] * pv + w1[n] * av[ai][m][n] + w2[n] * nv;
                    const f32x2 g01 = gelu_pk((f32x2){v[0], v[1]}), g23 = gelu_pk((f32x2){v[2], v[3]});
                    const f32x4 uu = uv[ai][m][n];
                    if (n == 0) { o.x = cvt_pk_bf16(g01.x * uu[0], g01.y * uu[1]); o.y = cvt_pk_bf16(g23.x * uu[2], g23.y * uu[3]); }
                    else { o.z = cvt_pk_bf16(g01.x * uu[0], g01.y * uu[1]); o.w = cvt_pk_bf16(g23.x * uu[2], g23.y * uu[3]); }
                }
                if (i >= 1 && i <= 254 && row < SLAB) *(u32x4*)(act + (size_t)row * FF + f0) = o;
            }
        }
    }
};

#define TR8(base, O0, O1, O2, O3, O4, O5, O6, O7, r) \
    asm volatile("ds_read_b64_tr_b16 %0, %8 offset:" #O0 "\n\tds_read_b64_tr_b16 %1, %8 offset:" #O1 "\n\tds_read_b64_tr_b16 %2, %8 offset:" #O2 "\n\tds_read_b64_tr_b16 %3, %8 offset:" #O3 "\n\t" \
                 "ds_read_b64_tr_b16 %4, %8 offset:" #O4 "\n\tds_read_b64_tr_b16 %5, %8 offset:" #O5 "\n\tds_read_b64_tr_b16 %6, %8 offset:" #O6 "\n\tds_read_b64_tr_b16 %7, %8 offset:" #O7 "\n\t" \
                 "s_waitcnt lgkmcnt(0)" \
                 : "=&v"(r[0]), "=&v"(r[1]), "=&v"(r[2]), "=&v"(r[3]), "=&v"(r[4]), "=&v"(r[5]), "=&v"(r[6]), "=&v"(r[7]) : "v"(base) : "memory")
__device__ __forceinline__ bf16x8 cat4(s16x4 lo, s16x4 hi) { return __builtin_shufflevector(lo, hi, 0, 1, 2, 3, 4, 5, 6, 7); }
__device__ __forceinline__ bf16x8 pack8(f32x4 a, f32x4 b) { u32x4 w; w.x = cvt_pk_bf16(a[0], a[1]); w.y = cvt_pk_bf16(a[2], a[3]); w.z = cvt_pk_bf16(b[0], b[1]); w.w = cvt_pk_bf16(b[2], b[3]); return __builtin_bit_cast(bf16x8, w); }
__device__ __forceinline__ unsigned lds_addr(LAS unsigned char* p) { return (unsigned)(size_t)p; }

constexpr int AP = 144;
struct AttnKV { u32x4 k[6], v[6]; };
__device__ __forceinline__ void attn_load(AttnKV& r, const bf16_t* qkvg, int item, int nbs) {
    const int tid = opaque_tid(), bi = item >> 1, hk = item & 1, bis = bi & (nbs - 1), row0 = bi * 128;
    const bool has_prev = bis > 0, has_next = bis < nbs - 1;
#pragma unroll
    for (int i = 0; i < 6; ++i) {
        const int c = tid + 512 * i, rr = c >> 3, ch = c & 7, jb = rr >> 7;
        const bool valid = (jb == 1) || (jb == 0 ? has_prev : has_next);
        r.k[i] = (u32x4){0u, 0u, 0u, 0u}; r.v[i] = (u32x4){0u, 0u, 0u, 0u};
        if (valid) { const bf16_t* p = qkvg + (size_t)(row0 - 128 + rr) * QW + 512 + hk * 64 + ch * 8; r.k[i] = *(const u32x4*)p; r.v[i] = *(const u32x4*)(p + 128); }
    }
}
__device__ __forceinline__ void attn_item(LAS unsigned char* lds, bf16_t* qkvg, const float* sink8, int item, int nbs, const AttnKV& kvr) {
    const int tid = opaque_tid(), lane = tid & 63, w = tid >> 6, g = lane >> 4, li = lane & 15, qq = li >> 2, pp = li & 3;
    const int bi = item >> 1, hk = item & 1, bis = bi & (nbs - 1), row0 = bi * 128;
    const bool has_prev = bis > 0, has_next = bis < nbs - 1;
    LAS unsigned char* Kl = lds; LAS unsigned char* Vl = lds + 384 * AP;
#pragma unroll
    for (int i = 0; i < 6; ++i) {
        const int c = tid + 512 * i, r = c >> 3, ch = c & 7;
        *(LAS u32x4*)(Kl + r * AP + ch * 16) = kvr.k[i]; *(LAS u32x4*)(Vl + r * AP + ch * 16) = kvr.v[i];
    }
    __syncthreads();
    const int head = hk * 4 + (w >> 1);
    const float sink = sink8[head] * 1.4426950408889634f;
    const unsigned vaddr0 = lds_addr(Vl) + (unsigned)((4 * g + qq) * AP + pp * 8);
#pragma unroll 1
    for (int pass = 0; pass < 4; ++pass) {
        const int qr0 = (w & 1) * 64 + pass * 16, r = qr0 + li;
        bf16_t* qp = qkvg + (size_t)(row0 + r) * QW + head * 64;
        const bf16x8 qf0 = *(const bf16x8*)(qp + 8 * g), qf1 = *(const bf16x8*)(qp + 32 + 8 * g);
        const int qt = qr0 >> 4;
        f32x4 st[24];
#pragma unroll
        for (int kt = 0; kt < 24; ++kt) {
            f32x4 a = (f32x4){0.f, 0.f, 0.f, 0.f};
            if (!((kt < 8 && kt < qt) || (kt >= 16 && kt - 16 > qt))) {
                LAS unsigned char* kp = Kl + (16 * kt + li) * AP + g * 16;
                a = mfma16(*(const LAS bf16x8*)kp, qf0, a); a = mfma16(*(const LAS bf16x8*)(kp + 64), qf1, a);
            }
            st[kt] = a;
        }
        float mx = sink;
#pragma unroll
        for (int kt = 0; kt < 24; ++kt)
#pragma unroll
            for (int j = 0; j < 4; ++j) {
                const int c = (16 * kt + 4 * g + j) & 127;
                const bool ok = (kt >= 8 && kt < 16) ? true : (kt < 8 ? (has_prev && c >= r) : (has_next && c <= r));
                st[kt][j] = ok ? st[kt][j] : -1e30f;
            }
#pragma unroll
        for (int kt = 0; kt < 24; ++kt) { mx = fmaxf(fmaxf(mx, st[kt][0]), st[kt][1]); mx = fmaxf(fmaxf(mx, st[kt][2]), st[kt][3]); }
        mx = fmaxf(mx, __shfl_xor(mx, 16)); mx = fmaxf(mx, __shfl_xor(mx, 32));
        float sum = 0.f;
#pragma unroll
        for (int kt = 0; kt < 24; ++kt)
#pragma unroll
            for (int j = 0; j < 4; ++j) { const float p = __builtin_amdgcn_exp2f(st[kt][j] - mx); st[kt][j] = p; sum += p; }
        sum += __shfl_xor(sum, 16); sum += __shfl_xor(sum, 32);
        const float inv = __builtin_amdgcn_rcpf(sum + __builtin_amdgcn_exp2f(sink - mx));
        f32x4 o[4];
#pragma unroll
        for (int dt = 0; dt < 4; ++dt) o[dt] = (f32x4){0.f, 0.f, 0.f, 0.f};
#pragma unroll
        for (int ks = 0; ks < 12; ++ks) {
            if ((ks < 4 && 2 * ks + 1 < qt) || (ks >= 8 && 2 * ks - 16 > qt)) continue;
            s16x4 tr[8];
            const unsigned addr = vaddr0 + (unsigned)(ks * 32 * AP);
            TR8(addr, 0, 32, 64, 96, 2304, 2336, 2368, 2400, tr);
            const bf16x8 pf = pack8(st[2 * ks], st[2 * ks + 1]);
#pragma unroll
            for (int dt = 0; dt < 4; ++dt) o[dt] = mfma16(cat4(tr[dt], tr[4 + dt]), pf, o[dt]);
        }
#pragma unroll
        for (int dt = 0; dt < 4; ++dt) {
            u32x2 wv; wv.x = cvt_pk_bf16(o[dt][0] * inv, o[dt][1] * inv); wv.y = cvt_pk_bf16(o[dt][2] * inv, o[dt][3] * inv);
            *(u32x2*)(qp + 16 * dt + 4 * g) = wv;
        }
    }
    __syncthreads();
}

constexpr int RP = 272;
constexpr int RT = 128 * RP;
struct StateKV { u32x4 k[4], v[4]; };
__device__ __forceinline__ void ret_state_load(StateKV& r, const bf16_t* qkvg, int item) {
    const int tid = opaque_tid(), cgi = item >> 2, h = item & 3, row0 = cgi * 128;
#pragma unroll
    for (int i = 0; i < 4; ++i) {
        const int c = tid + 512 * i, rr = c >> 4, ch = c & 15;
        const bf16_t* p = qkvg + (size_t)(row0 + rr) * QW + 1280 + h * 128 + ch * 8;
        r.k[i] = *(const u32x4*)p; r.v[i] = *(const u32x4*)(p + 512);
    }
}
__device__ __forceinline__ void ret_state_item(LAS unsigned char* lds, const bf16_t* qkvg, bf16_t* SF, bf16_t* SB, const float* lgf, const float* lgb, int item, const StateKV& kvr) {
    const int tid = opaque_tid(), lane = tid & 63, w = tid >> 6, g = lane >> 4, li = lane & 15, qq = li >> 2, pp = li & 3;
    const int cgi = item >> 2, h = item & 3;
    const float lf2 = lgf[h] * 1.4426950408889634f, lb2 = lgb[h] * 1.4426950408889634f;
    LAS unsigned char* Kf = lds; LAS unsigned char* Kb = lds + RT; LAS unsigned char* Vl = lds + 2 * RT;
#pragma unroll
    for (int i = 0; i < 4; ++i) {
        const int c = tid + 512 * i, r = c >> 4, ch = c & 15;
        const u32x4 kr = kvr.k[i], vr = kvr.v[i];
        const float zf = __builtin_amdgcn_exp2f(lf2 * (float)(127 - r)), zb = __builtin_amdgcn_exp2f(lb2 * (float)r);
        u32x4 kf, kb;
        kf.x = cvt_pk_bf16(bf_lo(kr.x) * zf, bf_hi(kr.x) * zf); kf.y = cvt_pk_bf16(bf_lo(kr.y) * zf, bf_hi(kr.y) * zf); kf.z = cvt_pk_bf16(bf_lo(kr.z) * zf, bf_hi(kr.z) * zf); kf.w = cvt_pk_bf16(bf_lo(kr.w) * zf, bf_hi(kr.w) * zf);
        kb.x = cvt_pk_bf16(bf_lo(kr.x) * zb, bf_hi(kr.x) * zb); kb.y = cvt_pk_bf16(bf_lo(kr.y) * zb, bf_hi(kr.y) * zb); kb.z = cvt_pk_bf16(bf_lo(kr.z) * zb, bf_hi(kr.z) * zb); kb.w = cvt_pk_bf16(bf_lo(kr.w) * zb, bf_hi(kr.w) * zb);
        *(LAS u32x4*)(Kf + r * RP + ch * 16) = kf; *(LAS u32x4*)(Kb + r * RP + ch * 16) = kb; *(LAS u32x4*)(Vl + r * RP + ch * 16) = vr;
    }
    __syncthreads();
    const unsigned lane_off = (unsigned)((8 * g + qq) * RP + pp * 8);
    s16x4 tv[8];
    { const unsigned a = lds_addr(Vl) + lane_off + (unsigned)(w * 32); TR8(a, 0, 8704, 17408, 26112, 1088, 9792, 18496, 27200, tv); }
    bf16x8 vf[4];
#pragma unroll
    for (int ks = 0; ks < 4; ++ks) vf[ks] = cat4(tv[ks], tv[4 + ks]);
#pragma unroll
    for (int dir = 0; dir < 2; ++dir) {
        bf16_t* ST = (dir ? SB : SF) + ((size_t)(cgi * 4 + h) * 128 + 16 * w + li) * 128 + 4 * g;
        const unsigned kbase = lds_addr(dir ? Kb : Kf) + lane_off;
#pragma unroll
        for (int dt = 0; dt < 8; ++dt) {
            s16x4 ta[8];
            const unsigned a = kbase + (unsigned)(dt * 32);
            TR8(a, 0, 8704, 17408, 26112, 1088, 9792, 18496, 27200, ta);
            f32x4 acc = (f32x4){0.f, 0.f, 0.f, 0.f};
#pragma unroll
            for (int ks = 0; ks < 4; ++ks) acc = mfma16(cat4(ta[ks], ta[4 + ks]), vf[ks], acc);
            u32x2 wv; wv.x = cvt_pk_bf16(acc[0], acc[1]); wv.y = cvt_pk_bf16(acc[2], acc[3]);
            *(u32x2*)(ST + 16 * dt) = wv;
        }
    }
    __syncthreads();
}

__device__ __forceinline__ void ret_scan(bf16_t* SF, bf16_t* SB, const float* lgf, const float* lgb, int nseq, int ncs, int gtid, int gthreads) {
    const int total = nseq * 4 * 2 * 4096;
    for (int idx = gtid; idx < total; idx += gthreads) {
        const int e4 = idx & 4095, dir = (idx >> 12) & 1, h = (idx >> 13) & 3, seq = idx >> 15;
        const float dec = __expf((dir ? lgb[h] : lgf[h]) * 128.0f);
        bf16_t* base = (dir ? SB : SF) + (size_t)h * 16384 + (size_t)e4 * 4;
        const int c0 = seq * ncs;
        float r0 = 0.f, r1 = 0.f, r2 = 0.f, r3 = 0.f;
        for (int cb = 0; cb < ncs; cb += 8) {
            u32x2 kv[8];
#pragma unroll
            for (int j = 0; j < 8; ++j) { const int c = dir ? (ncs - 1 - (cb + j)) : (cb + j); kv[j] = *(const u32x2*)(base + (size_t)(c0 + c) * 65536); }
#pragma unroll
            for (int j = 0; j < 8; ++j) { const int c = dir ? (ncs - 1 - (cb + j)) : (cb + j);
                u32x2 o; o.x = cvt_pk_bf16(r0, r1); o.y = cvt_pk_bf16(r2, r3);
                *(u32x2*)(base + (size_t)(c0 + c) * 65536) = o;
                r0 = r0 * dec + bf_lo(kv[j].x); r1 = r1 * dec + bf_hi(kv[j].x); r2 = r2 * dec + bf_lo(kv[j].y); r3 = r3 * dec + bf_hi(kv[j].y); }
        }
    }
}

__device__ __forceinline__ void ret_out_item(LAS unsigned char* lds, bf16_t* qkvg, const bf16_t* SF, const bf16_t* SB, const float* lgf, const float* lgb, const float* normg, int item) {
    const int tid = opaque_tid(), lane = tid & 63, w = tid >> 6, g = lane >> 4, li = lane & 15, qq = li >> 2, pp = li & 3;
    const int cgi = item >> 2, h = item & 3, row0 = cgi * 128;
    const float lf2 = lgf[h] * 1.4426950408889634f, lb2 = lgb[h] * 1.4426950408889634f;
    LAS unsigned char* Kl = lds; LAS unsigned char* Vl = lds + RT; LAS unsigned char* Rf = lds + 2 * RT; LAS unsigned char* Rb = lds + 3 * RT;
#pragma unroll
    for (int i = 0; i < 4; ++i) {
        const int c = tid + 512 * i, r = c >> 4, ch = c & 15;
        const bf16_t* p = qkvg + (size_t)(row0 + r) * QW + 1280 + h * 128 + ch * 8;
        const size_t so = ((size_t)(cgi * 4 + h) * 128 + r) * 128 + ch * 8;
        const u32x4 kr = *(const u32x4*)p, vr = *(const u32x4*)(p + 512), rf = *(const u32x4*)(SF + so), rb = *(const u32x4*)(SB + so);
        *(LAS u32x4*)(Kl + r * RP + ch * 16) = kr; *(LAS u32x4*)(Vl + r * RP + ch * 16) = vr; *(LAS u32x4*)(Rf + r * RP + ch * 16) = rf; *(LAS u32x4*)(Rb + r * RP + ch * 16) = rb;
    }
    const int n = 16 * w + li;
    bf16_t* qp = qkvg + (size_t)(row0 + n) * QW + 768 + h * 128;
    bf16x8 qf[4];
#pragma unroll
    for (int s = 0; s < 4; ++s) qf[s] = *(const bf16x8*)(qp + 32 * s + 8 * g);
    __syncthreads();
    f32x4 st[8];
#pragma unroll
    for (int kt = 0; kt < 8; ++kt) {
        LAS unsigned char* kp = Kl + (16 * kt + li) * RP + g * 16;
        f32x4 a = (f32x4){0.f, 0.f, 0.f, 0.f};
#pragma unroll
        for (int s = 0; s < 4; ++s) a = mfma16(*(const LAS bf16x8*)(kp + 64 * s), qf[s], a);
#pragma unroll
        for (int j = 0; j < 4; ++j) { const int dl = n - (16 * kt + 4 * g + j); a[j] *= __builtin_amdgcn_exp2f(dl >= 0 ? lf2 * (float)dl : -lb2 * (float)dl); }
        st[kt] = a;
    }
    f32x4 o[8], of[8], ob[8];
#pragma unroll
    for (int et = 0; et < 8; ++et) { o[et] = (f32x4){0.f, 0.f, 0.f, 0.f}; of[et] = o[et]; ob[et] = o[et]; }
    const unsigned vaddr0 = lds_addr(Vl) + (unsigned)((4 * g + qq) * RP + pp * 8);
#pragma unroll
    for (int ks = 0; ks < 4; ++ks) {
        s16x4 t0[8], t1[8];
        const unsigned addr = vaddr0 + (unsigned)(ks * 32 * RP);
        TR8(addr, 0, 32, 64, 96, 4352, 4384, 4416, 4448, t0);
        TR8(addr, 128, 160, 192, 224, 4480, 4512, 4544, 4576, t1);
        const bf16x8 pf = pack8(st[2 * ks], st[2 * ks + 1]);
#pragma unroll
        for (int et = 0; et < 4; ++et) { o[et] = mfma16(cat4(t0[et], t0[4 + et]), pf, o[et]); o[4 + et] = mfma16(cat4(t1[et], t1[4 + et]), pf, o[4 + et]); }
    }
#pragma unroll
    for (int et = 0; et < 8; ++et) {
        LAS unsigned char* fp = Rf + (16 * et + li) * RP + g * 16; LAS unsigned char* bp = Rb + (16 * et + li) * RP + g * 16;
#pragma unroll
        for (int s = 0; s < 4; ++s) { of[et] = mfma16(*(const LAS bf16x8*)(fp + 64 * s), qf[s], of[et]); ob[et] = mfma16(*(const LAS bf16x8*)(bp + 64 * s), qf[s], ob[et]); }
    }
    const float xf = __builtin_amdgcn_exp2f(lf2 * (float)(n + 1)), xb = __builtin_amdgcn_exp2f(lb2 * (float)(128 - n));
    float ss = 0.f;
#pragma unroll
    for (int et = 0; et < 8; ++et)
#pragma unroll
        for (int j = 0; j < 4; ++j) { const float v = o[et][j] + xf * of[et][j] + xb * ob[et][j]; o[et][j] = v; ss += v * v; }
    ss += __shfl_xor(ss, 16); ss += __shfl_xor(ss, 32);
    const float rinv = __builtin_amdgcn_rsqf(ss * (1.0f / 128.0f) + EPS);
#pragma unroll
    for (int et = 0; et < 8; ++et) {
        const int e0 = 16 * et + 4 * g;
        const u32x2 gr = *(const u32x2*)(qp + 1536 + e0);
        const f32x4 ng = *(const f32x4*)(normg + h * 128 + e0);
        const float g0 = bf_lo(gr.x), g1 = bf_hi(gr.x), g2 = bf_lo(gr.y), g3 = bf_hi(gr.y);
        const float v0 = o[et][0] * rinv * ng[0] * g0 * sigmoid_f(g0), v1 = o[et][1] * rinv * ng[1] * g1 * sigmoid_f(g1);
        const float v2 = o[et][2] * rinv * ng[2] * g2 * sigmoid_f(g2), v3 = o[et][3] * rinv * ng[3] * g3 * sigmoid_f(g3);
        u32x2 wv; wv.x = cvt_pk_bf16(v0, v1); wv.y = cvt_pk_bf16(v2, v3);
        *(u32x2*)(qp + e0) = wv;
    }
    __syncthreads();
}
struct Params {
    const float* x_prompt; const float* x_sample; const float* norm_mix_g; const float* w_in; const float* attn_sink; const float* lgf; const float* lgb; const float* ret_norm_g;
    const float* w_battn; const float* w_bret; const float* w_out; const float* norm_ffn_g; const float* w_ffn_in; const float* conv_w; const float* conv_b; const float* w_ffn_out; const float* final_g;
    float* out; unsigned char* ws;
};

__device__ __forceinline__ void transpose_item(const float* W, int K, int N, const float* gain, bf16_t* WT, int k0, int nsrc0, int prow0, LAS float* scr, int lane) {
    const int kr = lane >> 3, c4 = (lane & 7) * 4;
    f32x4 v[8];
#pragma unroll
    for (int i = 0; i < 8; ++i) v[i] = *(const f32x4*)(W + (size_t)(k0 + kr + 8 * i) * N + nsrc0 + c4);
#pragma unroll
    for (int i = 0; i < 8; ++i) { const float gsc = gain ? gain[k0 + kr + 8 * i] : 1.0f; LAS float* d = scr + (kr + 8 * i) * 33 + c4;
        d[0] = v[i][0] * gsc; d[1] = v[i][1] * gsc; d[2] = v[i][2] * gsc; d[3] = v[i][3] * gsc; }
    asm volatile("s_waitcnt lgkmcnt(0)" ::: "memory");
    const int c = lane & 7;
#pragma unroll
    for (int j = 0; j < 4; ++j) { const int n = (lane >> 3) + 8 * j; const LAS float* s = scr + (8 * c) * 33 + n;
        u32x4 o; o.x = cvt_pk_bf16(s[0 * 33], s[1 * 33]); o.y = cvt_pk_bf16(s[2 * 33], s[3 * 33]); o.z = cvt_pk_bf16(s[4 * 33], s[5 * 33]); o.w = cvt_pk_bf16(s[6 * 33], s[7 * 33]);
        *(u32x4*)(WT + (size_t)(prow0 + n) * K + k0 + 8 * c) = o; }
    asm volatile("s_waitcnt lgkmcnt(0)" ::: "memory");
}
__device__ __forceinline__ int win_src_col(int p0) {
    const int pn = p0 >> 8, p = p0 & 255, bj = p >> 7, j = p & 127;
    if (pn < 2) return 256 * pn + 64 * (j >> 5) + 32 * bj + (j & 31);
    if (pn == 2) return j < 64 ? 512 + 64 * (j >> 5) + 32 * bj + (j & 31) : 640 + 64 * bj + (j - 64);
    if (pn < 7) return 256 * pn + 128 * (j >> 6) + 64 * bj + (j & 63);
    return p0;
}
#if defined(__HIP_DEVICE_COMPILE__)
typedef const __attribute__((address_space(4))) Params* kparams_t;
__device__ __forceinline__ Params fresh_params() { kparams_t p = (kparams_t)__builtin_amdgcn_kernarg_segment_ptr(); asm volatile("" : "+s"(p)); return *p; }
#else
__device__ __forceinline__ Params fresh_params() { return Params{}; }
#endif
constexpr int I_IN = 16 * (INW / 32), I_BR = 8 * 32, I_OUT = 16 * 32, I_F1 = 16 * (FF2 / 32), I_F2 = (FF / 64) * 32, I_L = I_IN + 2 * I_BR + I_OUT + I_F1 + I_F2;
__device__ __forceinline__ void convert_weights(const Params& P, LAS unsigned char* lds, int it_lo, int it_hi, int wrank, int wcount) {
    const int tid = opaque_tid(), lane = tid & 63, w = tid >> 6;
    LAS float* scr = (LAS float*)(lds + w * 8448);
    for (int it = it_lo + wrank; it < it_hi; it += wcount) {
        const int l = it / I_L; int r = it % I_L;
        if (r < I_IN) { const int kb = r / (INW / 32), nb = r % (INW / 32);
            transpose_item(P.w_in + (size_t)l * DM * INW, DM, INW, P.norm_mix_g + l * DM, (bf16_t*)(P.ws + WS_WIN + l * SZ_WIN), 64 * kb, win_src_col(32 * nb), 32 * nb, scr, lane); continue; } r -= I_IN;
        if (r < I_BR) { const int kb = r / 32, nb = r % 32;
            transpose_item(P.w_battn + (size_t)l * 512 * DM, 512, DM, nullptr, (bf16_t*)(P.ws + WS_WBR + l * SZ_WBR), 64 * kb, 32 * nb, 32 * nb, scr, lane); continue; } r -= I_BR;
        if (r < I_BR) { const int kb = r / 32, nb = r % 32;
            transpose_item(P.w_bret + (size_t)l * 512 * DM, 512, DM, nullptr, (bf16_t*)(P.ws + WS_WBR + l * SZ_WBR), 64 * kb, 32 * nb, 1024 + 32 * nb, scr, lane); continue; } r -= I_BR;
        if (r < I_OUT) { const int kb = r / 32, nb = r % 32;
            transpose_item(P.w_out + (size_t)l * DM * DM, DM, DM, nullptr, (bf16_t*)(P.ws + WS_WOUT + l * SZ_WOUT), 64 * kb, 32 * nb, 32 * nb, scr, lane); continue; } r -= I_OUT;
        if (r < I_F1) { const int kb = r / (FF2 / 32), nb = r % (FF2 / 32);
            const int p0 = 32 * nb;
            transpose_item(P.w_ffn_in + (size_t)l * DM * FF2, DM, FF2, P.norm_ffn_g + l * DM, (bf16_t*)(P.ws + WS_WF1 + l * SZ_WF1), 64 * kb, ((p0 >> 7) & 1) * FF + 128 * (p0 >> 8) + (p0 & 127), p0, scr, lane); continue; } r -= I_F1;
        { const int kb = r / 32, nb = r % 32;
            transpose_item(P.w_ffn_out + (size_t)l * FF * DM, FF, DM, nullptr, (bf16_t*)(P.ws + WS_WF2 + l * SZ_WF2), 64 * kb, 32 * nb, 32 * nb, scr, lane); }
    }
}
template <int NR> __device__ __forceinline__ void convert_rows(const Params& P, int row_lo, int row_hi, int wrank, int wcount) {
    const int lane = opaque_tid() & 63;
    for (int row = row_lo + NR * wrank; row < row_hi; row += NR * wcount) {
        f32x4 v[NR][4];
#pragma unroll
        for (int r = 0; r < NR; ++r) { const int rr = row + r; const float* xr = rr < SLAB ? P.x_prompt + (size_t)rr * DM : P.x_sample + (size_t)(rr - SLAB) * DM;
#pragma unroll
            for (int j = 0; j < 4; ++j) v[r][j] = *(const f32x4*)(xr + 256 * j + 4 * lane); }
#pragma unroll
        for (int r = 0; r < NR; ++r) {
            bf16_t* xb = (bf16_t*)(P.ws + WS_XB) + (size_t)(row + r) * DM;
            float s = 0.f;
#pragma unroll
            for (int j = 0; j < 4; ++j) { const f32x4 x = v[r][j]; s += (x[0] * x[0] + x[1] * x[1]) + (x[2] * x[2] + x[3] * x[3]);
                u32x2 o; o.x = cvt_pk_bf16(x[0], x[1]); o.y = cvt_pk_bf16(x[2], x[3]); *(u32x2*)(xb + 256 * j + 4 * lane) = o; }
#pragma unroll
            for (int o = 1; o < 64; o <<= 1) s += __shfl_xor(s, o);
            if (lane < 16) ((float*)(P.ws + WS_SSQ))[(size_t)(row + r) * 16 + lane] = lane == 0 ? s : 0.f;
        }
    }
}
__device__ __forceinline__ void prologue_phase(const Params& P, LAS unsigned char* lds) {
    const int tid = opaque_tid(), w = tid >> 6;
    const int gw = blockIdx.x * 8 + w, ngw = gridDim.x * 8;
    convert_weights(P, lds, 0, I_IN, gw, ngw);
    const int gt = blockIdx.x * 512 + tid, ngt = gridDim.x * 512;
    for (int idx = gt; idx < 8192 * 96; idx += ngt) {
        const int pos = idx / 96, t = idx % 96, half = t < 32 ? 32 : 64, i = t < 32 ? t : t - 32;
        const double freq = exp2(-(double)i / (double)half * 13.287712379549449);
        const double turns = (double)pos * freq * 0.15915494309189535;
        const float fr = (float)(turns - rint(turns));
        f32x2 cs; cs.x = cospif(2.0f * fr); cs.y = sinpif(2.0f * fr);
        f32x2* dst = t < 32 ? (f32x2*)(P.ws + WS_ROPEA) + (size_t)pos * 32 + i : (f32x2*)(P.ws + WS_ROPER) + (size_t)pos * 64 + i;
        *dst = cs;
    }
    convert_rows<4>(P, 0, SLAB, gw, ngw);
}
__device__ __forceinline__ bool idle_rank(int nwg, int G, int c, int& rank, int& count) {
    const int rem = nwg % G;
    if (rem == 0) { rank = c; count = G; return true; }
    rank = c - rem; count = G - rem; return c >= rem;
}

__device__ __forceinline__ void final_norm_rows(const Params& P, int row_lo, int row_hi, int gw, int ngw) {
    const int lane = opaque_tid() & 63;
    const float* ssq = (const float*)(P.ws + WS_SSQ); const bf16_t* xball = (const bf16_t*)(P.ws + WS_XB);
    f32x4 gv[4];
#pragma unroll
    for (int j = 0; j < 4; ++j) gv[j] = *(const f32x4*)(P.final_g + 256 * j + 4 * lane);
    for (int row = row_lo + 2 * gw; row < row_hi; row += 2 * ngw) {
        u32x2 q[2][4]; float sv[2];
#pragma unroll
        for (int r = 0; r < 2; ++r) {
#pragma unroll
            for (int j = 0; j < 4; ++j) q[r][j] = *(const u32x2*)(xball + (size_t)(row + r) * DM + 256 * j + 4 * lane);
            sv[r] = lane < 16 ? ssq[(size_t)(row + r) * 16 + lane] : 0.f;
        }
#pragma unroll
        for (int r = 0; r < 2; ++r) {
            float s = sv[r];
#pragma unroll
            for (int o = 1; o < 16; o <<= 1) s += __shfl_xor(s, o);
            s = __shfl(s, 0);
            const float rinv = __builtin_amdgcn_rsqf(s * (1.0f / 1024.0f) + EPS);
            float* xr = P.out + (size_t)(row + r) * DM;
#pragma unroll
            for (int j = 0; j < 4; ++j) { f32x4 v = (f32x4){bf_lo(q[r][j].x), bf_hi(q[r][j].x), bf_lo(q[r][j].y), bf_hi(q[r][j].y)}; v = v * rinv * gv[j]; *(f32x4*)(xr + 256 * j + 4 * lane) = v; }
        }
    }
}

#define XB_TMO      128
#define XB_XCNT(j)  (256  + 64 * (j))
#define XB_XSUB(j)  (1280 + 64 * (j))
#define XB_XGEN(j)  (2304 + 64 * (j))
#define XB_TOP      3328
#define XB_TOPGEN   3392
#define XCD_BAR_WORDS 3456
#define XB_SPIN_CAP (1u << 18)

__device__ __forceinline__ unsigned xb_ld(unsigned* p)              { return __hip_atomic_load(p, __ATOMIC_RELAXED, __HIP_MEMORY_SCOPE_AGENT); }
__device__ __forceinline__ unsigned xb_add(unsigned* p, unsigned v) { return __hip_atomic_fetch_add(p, v, __ATOMIC_RELAXED, __HIP_MEMORY_SCOPE_AGENT); }
__device__ __forceinline__ unsigned xb_xcc_id() { return (unsigned)__builtin_amdgcn_s_getreg((3 << 11) | 20) & 0xFu; }
#define XB_SPIN(cond, bar) do { unsigned _sp = 0; while (cond) { __builtin_amdgcn_s_sleep(1); \
    if ((++_sp & 255u) == 0u) { if (xb_ld(&(bar)[XB_TMO])) break; if (_sp > XB_SPIN_CAP) { atomicAdd(&(bar)[XB_TMO], 1u); break; } } } } while (0)

struct XcdBarrier {
    unsigned* bar; unsigned x;
    volatile LAS unsigned* st;
};

__device__ __forceinline__ XcdBarrier xcd_barrier_post(unsigned* bar, volatile LAS unsigned* st) {
    XcdBarrier b; b.bar = bar; b.x = xb_xcc_id(); b.st = st;
    if (threadIdx.x == 0) (void)xb_add(&bar[XB_XCNT(b.x)], 1u);
    return b;
}
__device__ __forceinline__ void xcd_barrier_complete(unsigned* bar, unsigned x, unsigned& nloc, unsigned& nx) {
    const unsigned G = gridDim.x * gridDim.y * gridDim.z;
    unsigned sum, cnt, mine, sp = 0u;
    for (;;) {
        sum = 0u; cnt = 0u; mine = 0u;
#pragma unroll
        for (unsigned j = 0; j < 16; ++j) { const unsigned c = xb_ld(&bar[XB_XCNT(j)]); sum += c; cnt += (c > 0u) ? 1u : 0u; mine = (j == x) ? c : mine; }
        if (sum == G) break;
        __builtin_amdgcn_s_sleep(1);
        if ((++sp & 255u) == 0u) { if (xb_ld(&bar[XB_TMO])) break; if (sp > XB_SPIN_CAP) { atomicAdd(&bar[XB_TMO], 1u); break; } }
    }
    nloc = mine > 0u ? mine : 1u; nx = cnt > 0u ? cnt : 1u;
}

__device__ __forceinline__ void xcd_barrier(const XcdBarrier& b) {
    asm volatile("s_waitcnt vmcnt(0)" ::: "memory");
    __syncthreads();
    if (threadIdx.x == 0) {
        unsigned* bar = b.bar;
        __builtin_amdgcn_s_waitcnt(0);
        unsigned nloc = b.st[0], nx = b.st[1];
        if (nloc == 0u) { xcd_barrier_complete(bar, b.x, nloc, nx); b.st[0] = nloc; b.st[1] = nx; }
        const unsigned old = xb_add(&bar[XB_XSUB(b.x)], 1u);
        const unsigned gen = old / nloc;
        if (old + 1u == (gen + 1u) * nloc) {
            __builtin_amdgcn_fence(__ATOMIC_RELEASE, "agent");
            asm volatile("s_waitcnt vmcnt(0)" ::: "memory");
            const unsigned og = xb_add(&bar[XB_TOP], 1u);
            const unsigned tg = og / nx;
            if (og + 1u == (tg + 1u) * nx) xb_add(&bar[XB_TOPGEN], 1u);
            else XB_SPIN(xb_ld(&bar[XB_TOPGEN]) == tg, bar);
            __builtin_amdgcn_fence(__ATOMIC_ACQUIRE, "agent");
            xb_add(&bar[XB_XGEN(b.x)], 1u);
            asm volatile("s_waitcnt vmcnt(0)" ::: "memory");
        } else {
            XB_SPIN(xb_ld(&bar[XB_XGEN(b.x)]) == gen, bar);
            __builtin_amdgcn_fence(__ATOMIC_ACQUIRE, "agent");
            asm volatile("s_waitcnt vmcnt(0)" ::: "memory");
        }
    }
    __syncthreads();
}


#define GSYNC() xcd_barrier(gbar)
__global__ __launch_bounds__(512, 2) void fwd_megakernel(Params P) {
    extern __shared__ __attribute__((aligned(16))) unsigned char shm[];
    LAS unsigned char* lds = (LAS unsigned char*)shm;
    cg::grid_group grid = cg::this_grid();
    const int G = gridDim.x, c = blockIdx.x;
    volatile LAS unsigned* xst = (volatile LAS unsigned*)(lds + LDS_BYTES - 16);
    if (threadIdx.x == 0) { xst[0] = 0u; xst[1] = 0u; }
    __syncthreads();
    const XcdBarrier gbar = xcd_barrier_post((unsigned*)(P.ws + WS_BAR), xst);
    prologue_phase(fresh_params(), lds);
    grid.sync();
#pragma unroll 1
    for (int l = 0; l < DEPTH; ++l) {
#pragma unroll 1
        for (int s = 0; s < NSLAB; ++s) {
#define SLAB_PTRS const Params Q = fresh_params(); const size_t r0 = (size_t)s * SLAB; unsigned char* SLB = Q.ws + WS_SLAB; \
            bf16_t* xb = (bf16_t*)(Q.ws + WS_XB) + r0 * DM; float* ssq = (float*)(Q.ws + WS_SSQ) + r0 * 16; float* xo = Q.out + r0 * DM; \
            bf16_t* qkvg = (bf16_t*)(SLB + SL_QKVG); bf16_t* gates = (bf16_t*)(SLB + SL_GATES); bf16_t* SF = (bf16_t*)(SLB + SL_SF); bf16_t* SB = (bf16_t*)(SLB + SL_SB); \
            bf16_t* merged = (bf16_t*)(SLB + SL_MERGED); bf16_t* act = (bf16_t*)(SLB + SL_ACT); \
            (void)xb; (void)ssq; (void)xo; (void)qkvg; (void)gates; (void)SF; (void)SB; (void)merged; (void)act
            {
                SLAB_PTRS;
                pg8::Gemm g{xb, xb, (const bf16_t*)(Q.ws + WS_WIN + l * SZ_WIN), DM, DM, DM};
                pg8::StaticOrder S; S.init(SLAB, INW, G, c);
                EpiProj E{qkvg, gates, ssq, (const f32x4*)(Q.ws + WS_ROPEA), (const f32x4*)(Q.ws + WS_ROPER), s == 0 ? 2047 : 8191};
                pg8::gemm_phase(lds, g, S, E);
                if (l == 0 && s < 2) { int rk, cnt;
                    if (idle_rank(S.nwg, G, c, rk, cnt)) { const Params PF = fresh_params(); const int wr_ = rk * 8 + (opaque_tid() >> 6), wc_ = cnt * 8;
                        if (s == 0) convert_weights(PF, lds, I_IN, I_L - I_F2, wr_, wc_); else convert_rows<2>(PF, 2 * SLAB, T_ALL, wr_, wc_); } }
            }
            GSYNC();
            {
                SLAB_PTRS;
                const int nbs = s == 0 ? 16 : 64;
                for (int a0 = c; a0 < 256; a0 += G) {
                    const int a = G == 256 ? (((a0 & 7) * 16 + (a0 >> 4)) * 2 + ((a0 >> 3) & 1)) : a0;
                    StateKV k0, k1; AttnKV k2;
                    ret_state_load(k0, qkvg, a);
                    ret_state_load(k1, qkvg, a + 256);
                    ret_state_item(lds, qkvg, SF, SB, Q.lgf + l * 4, Q.lgb + l * 4, a, k0);
                    attn_load(k2, qkvg, a, nbs);
                    ret_state_item(lds, qkvg, SF, SB, Q.lgf + l * 4, Q.lgb + l * 4, a + 256, k1);
                    attn_item(lds, qkvg, Q.attn_sink + l * 8, a, nbs, k2);
                }
            }
            GSYNC();
            {
                SLAB_PTRS;
                ret_scan(SF, SB, Q.lgf + l * 4, Q.lgb + l * 4, s == 0 ? 8 : 2, s == 0 ? 16 : 64, c * 512 + opaque_tid(), G * 512);
            }
            GSYNC();
            {
                SLAB_PTRS;
                for (int it = c; it < 512; it += G) ret_out_item(lds, qkvg, SF, SB, Q.lgf + l * 4, Q.lgb + l * 4, Q.ret_norm_g + l * 512, it);
            }
            GSYNC();
            {
                SLAB_PTRS;
                pg8::Gemm g{qkvg, qkvg + 768, (const bf16_t*)(Q.ws + WS_WBR + l * SZ_WBR), 512, QW, 512};
                pg8::MergeOrder S; S.init(SLAB, G, c);
                EpiMerge E{merged, gates};
                pg8::gemm_phase(lds, g, S, E);
            }
            GSYNC();
            {
                SLAB_PTRS;
                pg8::Gemm g{merged, merged, (const bf16_t*)(Q.ws + WS_WOUT + l * SZ_WOUT), DM, DM, DM};
                pg8::StaticOrder S; S.init(SLAB, DM, G, c);
                if (l == 0) { EpiResid<true> E{s == 0 ? Q.x_prompt : Q.x_sample + (size_t)(s - 1) * SLAB * DM, xb, ssq}; pg8::gemm_phase(lds, g, S, E); }
                else { EpiResid<false> E{nullptr, xb, ssq}; pg8::gemm_phase(lds, g, S, E); }
            }
            GSYNC();
            {
                SLAB_PTRS;
                pg8::Gemm g{xb, xb, (const bf16_t*)(Q.ws + WS_WF1 + l * SZ_WF1), DM, DM, DM};
                pg8::FfnOrder S4; S4.init(65, FF2, G, c);
                EpiFfnConv E{act, ssq, Q.conv_w + (size_t)l * 3 * FF, Q.conv_b + (size_t)l * FF, (LAS float*)(lds + 131072), s == 0 ? 2048 : 8192};
                pg8::gemm_phase(lds, g, S4, E);
                if (l == 0 && s < 2) { int rk, cnt;
                    if (idle_rank(S4.so.nwg, G, c, rk, cnt)) { const Params PF = fresh_params(); const int wr_ = rk * 8 + (opaque_tid() >> 6), wc_ = cnt * 8;
                        if (s == 0) { convert_weights(PF, lds, I_L - I_F2, I_L + I_IN, wr_, wc_); convert_rows<2>(PF, SLAB, 2 * SLAB, wr_, wc_); }
                        else convert_weights(PF, lds, I_L + I_IN, 2 * I_L, wr_, wc_); } }
                if (l == DEPTH - 1 && s >= 1) { int rk, cnt;
                    if (idle_rank(S4.so.nwg, G, c, rk, cnt)) final_norm_rows(fresh_params(), (s - 1) * SLAB, s * SLAB, rk * 8 + (opaque_tid() >> 6), cnt * 8); }
            }
            GSYNC();
            {
                SLAB_PTRS;
                pg8::Gemm g{act, act, (const bf16_t*)(Q.ws + WS_WF2 + l * SZ_WF2), FF, FF, FF};
                pg8::StaticOrder S; S.init(SLAB, DM, G, c);
                EpiResid<false> E{nullptr, xb, ssq};
                pg8::gemm_phase(lds, g, S, E);
            }
            GSYNC();
#undef SLAB_PTRS
        }
    }
    final_norm_rows(fresh_params(), 2 * SLAB, T_ALL, c * 8 + (opaque_tid() >> 6), G * 8);
}

extern "C" void kernel_launch(void* const* d_in, const int* in_sizes, int n_in, void* d_out, int out_size, void* d_ws, size_t ws_size, hipStream_t stream) {
    static int grid_blocks = 0;
    if (!grid_blocks) {
        int dev = 0, cus = 0, per_cu = 0;
        hipGetDevice(&dev);
        hipDeviceGetAttribute(&cus, hipDeviceAttributeMultiprocessorCount, dev);
        hipFuncSetAttribute((const void*)fwd_megakernel, hipFuncAttributeMaxDynamicSharedMemorySize, LDS_BYTES);
        hipOccupancyMaxActiveBlocksPerMultiprocessor(&per_cu, (const void*)fwd_megakernel, 512, LDS_BYTES);
        if (per_cu < 1) per_cu = 1;
        grid_blocks = cus * per_cu;
        if (ws_size < WS_END) fprintf(stderr, "workspace too small: %zu < %zu\n", ws_size, (size_t)WS_END);
    }
    if (hipMemsetAsync((unsigned char*)d_ws + WS_BAR, 0, 16384, stream) != hipSuccess) fprintf(stderr, "memset of the barrier words failed\n");
    Params p{};
    p.x_prompt = (const float*)d_in[0]; p.x_sample = (const float*)d_in[1]; p.norm_mix_g = (const float*)d_in[2]; p.w_in = (const float*)d_in[3]; p.attn_sink = (const float*)d_in[4];
    p.lgf = (const float*)d_in[5]; p.lgb = (const float*)d_in[6]; p.ret_norm_g = (const float*)d_in[7]; p.w_battn = (const float*)d_in[8]; p.w_bret = (const float*)d_in[9]; p.w_out = (const float*)d_in[10];
    p.norm_ffn_g = (const float*)d_in[11]; p.w_ffn_in = (const float*)d_in[12]; p.conv_w = (const float*)d_in[13]; p.conv_b = (const float*)d_in[14]; p.w_ffn_out = (const float*)d_in[15]; p.final_g = (const float*)d_in[16];
    p.out = (float*)d_out; p.ws = (unsigned char*)d_ws;
    void* args[] = {&p};
    hipError_t e = hipLaunchCooperativeKernel((const void*)fwd_megakernel, dim3(grid_blocks), dim3(512), args, LDS_BYTES, stream);
    if (e != hipSuccess) fprintf(stderr, "cooperative launch failed: %s (grid %d)\n", hipGetErrorString(e), grid_blocks);
}
```
